# Optimizing an MI355X kernel written in HIP

```python
import jax, jax.numpy as jnp
from jax import lax
import numpy as np

D_MODEL = 1024
BATCH = 8
SEQ = 4096
DEPTH = 4
DEC_BATCH = 16
DEC_SEQ = 16
PAST_LEN = 4096

CHUNK = 64
EPS = 1e-6
N_EVEN = (DEPTH + 1) // 2
N_ODD = DEPTH // 2

A_HEADS = 4
A_EXPAND = 128
A_HEAD_DIM = D_MODEL // 8
A_KEY_WIDTH = A_HEADS * A_EXPAND
A_WIDTH = A_HEADS * A_HEAD_DIM
POOL_WINDOWS = (2, 4, 8, 16)
B_GROUPS = len(POOL_WINDOWS)
B_GROUP_DIM = D_MODEL // 8
B_WIDTH = B_GROUPS * B_GROUP_DIM
POOL_HIST = max(POOL_WINDOWS) - 1
AB_IN = 2 * A_KEY_WIDTH + 2 * A_WIDTH + B_WIDTH
AB_OUT = A_WIDTH + B_WIDTH
C_BLOCK = 128
C_GROUPS = 8
C_WIDTH = 2 * D_MODEL
C_GROUP_DIM = C_WIDTH // C_GROUPS
D_FF = 2816
CONV_W = 3

kernel_name = "hgrn2_pool_cmlp_streaming_step"


def rms_norm(x, gain):
    xf = x.astype(jnp.float32)
    y = xf * lax.rsqrt(jnp.mean(xf * xf, axis=-1, keepdims=True) + EPS)
    return (y * gain.astype(jnp.float32)).astype(x.dtype)


def layer_norm(x, gain, bias):
    xf = x.astype(jnp.float32)
    mu = jnp.mean(xf, axis=-1, keepdims=True)
    xc = xf - mu
    y = xc * lax.rsqrt(jnp.mean(xc * xc, axis=-1, keepdims=True) + EPS)
    return (y * gain.astype(jnp.float32) + bias.astype(jnp.float32)).astype(x.dtype)


def hgrn_lower_bounds(lb_logits):
    p = jax.nn.softmax(lb_logits.astype(jnp.float32), axis=0)
    c = jnp.cumsum(p, axis=0)
    return c - c[0:1]


def hgrn2_recurrence(q, k, log_f, v, s0):
    B, T, H, K = q.shape
    V = v.shape[-1]
    L = min(CHUNK, T)
    n = T // L

    def to_blocks(a):
        return a.astype(jnp.float32).reshape(B, n, L, H, a.shape[-1]).transpose(1, 0, 3, 2, 4)

    qc, kc, gc, vc = to_blocks(q), to_blocks(k), to_blocks(log_f), to_blocks(v)
    causal = jnp.tril(jnp.ones((L, L), dtype=bool))

    def step(S, inp):
        qb, kb, gb, vb = inp
        b = jnp.cumsum(gb, axis=2)
        rel = b[:, :, :, None, :] - b[:, :, None, :, :]
        decay = jnp.exp(jnp.where(causal[:, :, None], rel, -jnp.inf))
        scores = jnp.einsum('bhtk,bhsk,bhtsk->bhts', qb, kb, decay)
        o = (jnp.einsum('bhts,bhsv->bhtv', scores, vb)
             + jnp.einsum('bhtk,bhkv->bhtv', qb * jnp.exp(b), S))
        b_last = b[:, :, -1:, :]
        S_new = (jnp.exp(b_last[:, :, 0, :])[..., None] * S
                 + jnp.einsum('bhsk,bhsv->bhkv', kb * jnp.exp(b_last - b), vb))
        return S_new, o

    S_fin, oc = lax.scan(step, s0.astype(jnp.float32), (qc, kc, gc, vc))
    o = oc.transpose(1, 0, 3, 2, 4).reshape(B, T, H, V)
    return o, S_fin.astype(s0.dtype)


def multiscale_pool(p, hist, pos0, pool_w, pool_scale):
    B, T, _ = p.shape
    full = jnp.concatenate([hist.astype(p.dtype), p], axis=1).astype(jnp.float32)
    cs = jnp.concatenate([jnp.zeros((B, 1, B_WIDTH), jnp.float32), jnp.cumsum(full, axis=1)], axis=1)
    pos = pos0 + jnp.arange(T)
    cur = full[:, POOL_HIST:]
    outs = []
    for gi, w in enumerate(POOL_WINDOWS):
        sl = slice(gi * B_GROUP_DIM, (gi + 1) * B_GROUP_DIM)
        end = cs[:, POOL_HIST + 1:POOL_HIST + 1 + T, sl]
        start = cs[:, POOL_HIST + 1 - w:POOL_HIST + 1 - w + T, sl]
        cnt = jnp.minimum(pos + 1, w).astype(jnp.float32)[None, :, None]
        outs.append((end - start) / cnt - cur[:, :, sl])
    pooled = jnp.concatenate(outs, axis=-1).reshape(B, T, B_GROUPS, B_GROUP_DIM)
    y = jnp.einsum('btgc,gce->btge', pooled, pool_w.astype(jnp.float32)).reshape(B, T, B_WIDTH)
    y = y * pool_scale.astype(jnp.float32)
    return y.astype(p.dtype), full[:, -POOL_HIST:].astype(hist.dtype)


def ab_mixer(h, s_hgrn, pool_hist, pos0, lb, w_in, out_gain, pool_w, pool_scale, w_out):
    B, T, _ = h.shape
    proj = jnp.einsum('btd,de->bte', h, w_in)
    o1 = A_KEY_WIDTH
    o2 = 2 * A_KEY_WIDTH
    o3 = o2 + A_WIDTH
    o4 = o3 + A_WIDTH
    q, fz, i_in, g, p = proj[..., :o1], proj[..., o1:o2], proj[..., o2:o3], proj[..., o3:o4], proj[..., o4:]
    fz = fz.astype(jnp.float32)
    log_f = jnp.logaddexp(jnp.log(lb), jnp.log1p(-lb) + jax.nn.log_sigmoid(fz))
    k = (1.0 - lb) * jax.nn.sigmoid(-fz)
    q = jax.nn.silu(q.astype(jnp.float32)) * (A_EXPAND ** -0.5)
    heads = lambda a, d: a.reshape(B, T, A_HEADS, d)
    o, s_new = hgrn2_recurrence(heads(q, A_EXPAND), heads(k, A_EXPAND), heads(log_f, A_EXPAND),
                                heads(i_in, A_HEAD_DIM), s_hgrn)
    o = rms_norm(o, out_gain) * jax.nn.silu(heads(g, A_HEAD_DIM).astype(jnp.float32))
    o = o.reshape(B, T, A_WIDTH).astype(h.dtype)
    yb, pool_new = multiscale_pool(p, pool_hist, pos0, pool_w, pool_scale)
    mix = jnp.einsum('bte,ed->btd', jnp.concatenate([o, yb], axis=-1), w_out)
    return mix, s_new, pool_new


def chunk_mlp_mixer(h, w_uv, ln_gain, ln_bias, ws, bs, w_out):
    B, T, _ = h.shape
    z = jax.nn.gelu(jnp.einsum('btd,de->bte', h, w_uv), approximate=False)
    u, v = z[..., :C_WIDTH], z[..., C_WIDTH:]
    v = layer_norm(v, ln_gain, ln_bias)
    L = min(C_BLOCK, T)
    n = T // L
    idx = jnp.arange(L)
    mask = (idx[None, :] // CHUNK) <= (idx[:, None] // CHUNK)
    w = jnp.where(mask[None], ws[:, :L, :L], 0.0)
    vc = v.reshape(B, n, L, C_GROUPS, C_GROUP_DIM)
    mixed = (jnp.einsum('gts,bnsgc->bntgc', w, vc)
             + bs[:, :L].T[None, None, :, :, None])
    y = u * mixed.reshape(B, T, C_WIDTH).astype(u.dtype)
    return jnp.einsum('bte,ed->btd', y, w_out), v


def conv_ffn(h, conv_hist, w_in, conv_w, conv_b, w_out):
    T = h.shape[1]
    proj = jnp.einsum('btd,df->btf', h, w_in)
    a, gate = proj[..., :D_FF], proj[..., D_FF:]
    full = jnp.concatenate([conv_hist.astype(a.dtype), a], axis=1)
    conv = conv_b + sum(full[:, j:j + T] * conv_w[j] for j in range(CONV_W))
    y = jnp.einsum('btf,fd->btd', jax.nn.gelu(conv, approximate=False) * gate, w_out)
    return y, full[:, -(CONV_W - 1):].astype(conv_hist.dtype)


def trunk(x, s_hgrn, s_pool, s_conv, pos0, lbs, norm_mix, norm_ffn, norm_final, w_in_ab, hgrn_out_gain,
          pool_w, pool_scale, w_out_ab, w_uv_c, c_ln_gain, c_ln_bias, c_ws, c_bs, w_out_c,
          w_in_ffn, ffn_conv_w, ffn_conv_b, w_out_ffn):
    new_hgrn, new_pool, new_conv, new_cv = [], [], [], []
    for layer in range(DEPTH):
        h = rms_norm(x, norm_mix[layer])
        if layer % 2 == 0:
            e = layer // 2
            mix, sh, sp = ab_mixer(h, s_hgrn[e], s_pool[e], pos0, lbs[e], w_in_ab[e], hgrn_out_gain[e],
                                   pool_w[e], pool_scale[e], w_out_ab[e])
            new_hgrn.append(sh)
            new_pool.append(sp)
        else:
            o = layer // 2
            mix, v = chunk_mlp_mixer(h, w_uv_c[o], c_ln_gain[o], c_ln_bias[o], c_ws[o], c_bs[o], w_out_c[o])
            new_cv.append(v)
        x = x + mix.astype(x.dtype)
        h = rms_norm(x, norm_ffn[layer])
        f, sc = conv_ffn(h, s_conv[layer], w_in_ffn[layer], ffn_conv_w[layer], ffn_conv_b[layer], w_out_ffn[layer])
        new_conv.append(sc)
        x = x + f.astype(x.dtype)
    y = rms_norm(x, norm_final)
    return y, jnp.stack(new_hgrn), jnp.stack(new_pool), jnp.stack(new_conv), jnp.stack(new_cv)


def setup_inputs(seed: int = 0) -> dict:
    key = jax.random.key(seed)
    ks = jax.random.split(key, 24)
    f32 = jnp.float32

    def nrm(k, shape, scale):
        return scale * jax.random.normal(k, shape, f32)

    def gain(k, shape):
        return 1.0 + 0.05 * jax.random.normal(k, shape, f32)

    return {
        "x_prompt": nrm(ks[0], (BATCH, SEQ, D_MODEL), 1.0),
        "x_sample": nrm(ks[1], (DEC_BATCH, DEC_SEQ, D_MODEL), 1.0),
        "state_hgrn": nrm(ks[2], (N_EVEN, DEC_BATCH, A_HEADS, A_EXPAND, A_HEAD_DIM), 0.3),
        "state_pool": nrm(ks[3], (N_EVEN, DEC_BATCH, POOL_HIST, B_WIDTH), 1.0),
        "state_ffn_conv": nrm(ks[4], (DEPTH, DEC_BATCH, CONV_W - 1, D_FF), 1.0),
        "norm_mix": gain(ks[5], (DEPTH, D_MODEL)),
        "norm_ffn": gain(ks[6], (DEPTH, D_MODEL)),
        "norm_final": gain(ks[7], (D_MODEL,)),
        "hgrn_lb_logits": nrm(ks[8], (N_EVEN, A_KEY_WIDTH), 0.5),
        "w_in_ab": nrm(ks[9], (N_EVEN, D_MODEL, AB_IN), D_MODEL ** -0.5),
        "hgrn_out_gain": gain(ks[10], (N_EVEN, A_HEAD_DIM)),
        "pool_w": nrm(ks[11], (N_EVEN, B_GROUPS, B_GROUP_DIM, B_GROUP_DIM), B_GROUP_DIM ** -0.5),
        "pool_scale": gain(ks[12], (N_EVEN, B_WIDTH)),
        "w_out_ab": nrm(ks[13], (N_EVEN, AB_OUT, D_MODEL), AB_OUT ** -0.5),
        "w_uv_c": nrm(ks[14], (N_ODD, D_MODEL, 2 * C_WIDTH), D_MODEL ** -0.5),
        "c_ln_gain": gain(ks[15], (N_ODD, C_WIDTH)),
        "c_ln_bias": nrm(ks[16], (N_ODD, C_WIDTH), 0.02),
        "c_ws": nrm(ks[17], (N_ODD, C_GROUPS, C_BLOCK, C_BLOCK), C_BLOCK ** -0.5),
        "c_bs": gain(ks[18], (N_ODD, C_GROUPS, C_BLOCK)),
        "w_out_c": nrm(ks[19], (N_ODD, C_WIDTH, D_MODEL), C_WIDTH ** -0.5),
        "w_in_ffn": nrm(ks[20], (DEPTH, D_MODEL, 2 * D_FF), D_MODEL ** -0.5),
        "ffn_conv_w": nrm(ks[21], (DEPTH, CONV_W, D_FF), CONV_W ** -0.5),
        "ffn_conv_b": nrm(ks[22], (DEPTH, D_FF), 0.02),
        "w_out_ffn": nrm(ks[23], (DEPTH, D_FF, D_MODEL), D_FF ** -0.5),
    }


def reference(x_prompt, x_sample, state_hgrn, state_pool, state_ffn_conv, norm_mix, norm_ffn, norm_final,
              hgrn_lb_logits, w_in_ab, hgrn_out_gain, pool_w, pool_scale, w_out_ab, w_uv_c, c_ln_gain,
              c_ln_bias, c_ws, c_bs, w_out_c, w_in_ffn, ffn_conv_w, ffn_conv_b, w_out_ffn):
    lbs = hgrn_lower_bounds(hgrn_lb_logits)
    weights = (norm_mix, norm_ffn, norm_final, w_in_ab, hgrn_out_gain, pool_w, pool_scale, w_out_ab,
               w_uv_c, c_ln_gain, c_ln_bias, c_ws, c_bs, w_out_c, w_in_ffn, ffn_conv_w, ffn_conv_b, w_out_ffn)
    bp = x_prompt.shape[0]
    zero_hgrn = jnp.zeros((N_EVEN, bp, A_HEADS, A_EXPAND, A_HEAD_DIM), state_hgrn.dtype)
    zero_pool = jnp.zeros((N_EVEN, bp, POOL_HIST, B_WIDTH), state_pool.dtype)
    zero_conv = jnp.zeros((DEPTH, bp, CONV_W - 1, D_FF), state_ffn_conv.dtype)
    y_prompt, hgrn_prompt, pool_prompt, conv_prompt, _ = trunk(
        x_prompt, zero_hgrn, zero_pool, zero_conv, 0, lbs, *weights)
    y_sample, hgrn_sample, pool_sample, conv_sample, cmlp_v_sample = trunk(
        x_sample, state_hgrn, state_pool, state_ffn_conv, PAST_LEN, lbs, *weights)
    return (y_prompt, y_sample, hgrn_prompt, hgrn_sample, pool_prompt, pool_sample,
            conv_prompt, conv_sample, cmlp_v_sample)
```

```cpp
#include <hip/hip_runtime.h>
#include <hip/hip_cooperative_groups.h>
#include <cstdio>
namespace cg = cooperative_groups;

#ifndef MULTI_LAUNCH
#define MULTI_LAUNCH 0
#endif

#ifndef PH_CUT
#define PH_CUT 100
#define DBG_PHASE 19
#define DBG_KIND 0
#endif
#ifndef DUP
#define DUP 0
#endif
#ifndef PHM
#define PHM 0xFFFF
#endif
#define LAS __attribute__((address_space(3)))
typedef unsigned short bf16_t;
typedef short bf16x8 __attribute__((ext_vector_type(8)));
typedef float f32x4 __attribute__((ext_vector_type(4)));
typedef float f32x2 __attribute__((ext_vector_type(2)));
typedef unsigned u32x4 __attribute__((ext_vector_type(4)));
typedef unsigned u32x2 __attribute__((ext_vector_type(2)));

constexpr int MP = 32768, MS = 256, MA = MP + MS;
constexpr float EPS = 1e-6f;
constexpr int NTHR = 512;
constexpr int LDS_BYTES = 131072 + 4096 + 16;

constexpr size_t al256(size_t x) { return (x + 255) & ~(size_t)255; }
constexpr size_t WS_SS = 0;
constexpr size_t WS_VST = al256(WS_SS + (size_t)9 * MA * 16 * 4);
constexpr size_t WS_LB = al256(WS_VST + (size_t)MA * 64 * 4);
constexpr size_t WS_W0 = al256(WS_LB + 4096);
constexpr size_t SLOT_ELEMS = 14942208;
constexpr size_t SLOT_BYTES = SLOT_ELEMS * 2;
constexpr size_t WS_XB = al256(WS_W0 + 2 * SLOT_BYTES);
constexpr size_t WS_R = al256(WS_XB + (size_t)MA * 1024 * 2);
constexpr size_t R_PROJ = 0;
constexpr size_t R_LF = al256((size_t)MA * 2560 * 2);
constexpr size_t R_A2 = al256(R_LF + (size_t)MA * 512 * 4);
constexpr size_t R_ST = al256(R_A2 + (size_t)MA * 1024 * 2);
constexpr size_t R_DEC = al256(R_ST + (size_t)2048 * 16384 * 2);
constexpr size_t R_EVEN_END = R_DEC + (size_t)2048 * 128 * 4;
constexpr size_t R_Y = 0;
constexpr size_t R_EDGE = al256((size_t)MA * 2816 * 2);
constexpr size_t R_SBUF = al256(R_EDGE + (size_t)128 * 12 * 2816 * 4);
constexpr size_t R_FFN_END = R_SBUF + (size_t)256 * 5632 * 2;
constexpr size_t R_SIZE = R_EVEN_END > R_FFN_END ? R_EVEN_END : R_FFN_END;
constexpr size_t WS_BAR = al256(WS_R + R_SIZE);
constexpr size_t WS_END = WS_BAR + 3456 * 4;

constexpr size_t O_Y = 0;
constexpr size_t O_HP = (size_t)MA * 1024;
constexpr size_t O_HS = O_HP + (size_t)2 * 8 * 4 * 16384;
constexpr size_t O_PP = O_HS + (size_t)2 * 16 * 4 * 16384;
constexpr size_t O_PS = O_PP + (size_t)2 * 8 * 15 * 512;
constexpr size_t O_CP = O_PS + (size_t)2 * 16 * 15 * 512;
constexpr size_t O_CS = O_CP + (size_t)4 * 8 * 2 * 2816;
constexpr size_t O_CV = O_CS + (size_t)4 * 16 * 2 * 2816;
constexpr size_t O_END = O_CV + (size_t)2 * 16 * 16 * 2048;

struct Params { const float* in[24]; float* out; unsigned char* ws; int ph_lo, ph_hi, dbg, pad; };

__device__ __forceinline__ int fresh_tid() { int t = threadIdx.x; asm volatile("" : "+v"(t)); return t; }
typedef __bf16 bf16x2_t __attribute__((ext_vector_type(2)));
__device__ __forceinline__ unsigned cvt_pk_bf16(float lo, float hi) { const f32x2 v = {lo, hi}; const bf16x2_t b = __builtin_convertvector(v, bf16x2_t); return __builtin_bit_cast(unsigned, b); }
__device__ __forceinline__ bf16_t f2bf(float f) { return (bf16_t)(cvt_pk_bf16(f, 0.f) & 0xffffu); }
__device__ __forceinline__ float bf2f(bf16_t b) { return __uint_as_float(((unsigned)b) << 16); }
__device__ __forceinline__ float bflo(unsigned u) { return __uint_as_float(u << 16); }
__device__ __forceinline__ float bfhi(unsigned u) { return __uint_as_float(u & 0xffff0000u); }
__device__ __forceinline__ float sigmoidf_(float x) { return __builtin_amdgcn_rcpf(1.0f + __expf(-x)); }
__device__ __forceinline__ float clampe(float x) { return fminf(fmaxf(x, -80.f), 80.f); }
__device__ __forceinline__ f32x2 gelu_pk(f32x2 v) {
    const f32x2 av = __builtin_elementwise_abs(v), d = av * 0.2316418882f + 1.0f;
    f32x2 t; t.x = __builtin_amdgcn_rcpf(d.x); t.y = __builtin_amdgcn_rcpf(d.y);
    f32x2 q = t * 0.5307027145f + (-0.7265760135f); q = q * t + 0.7107068705f; q = q * t + (-0.142248368f); q = q * t + 0.127414796f; q = q * t;
    const f32x2 s = (v * v) * (-0.72134752044f);
    f32x2 e; e.x = __builtin_amdgcn_exp2f(s.x); e.y = __builtin_amdgcn_exp2f(s.y);
    return av * (0.5f - q * e) + 0.5f * v;
}
__device__ __forceinline__ float gelu1(float x) { f32x2 r = gelu_pk((f32x2){x, 0.f}); return r.x; }
__device__ __forceinline__ f32x4 gelu4(f32x4 v) { f32x2 a = gelu_pk((f32x2){v[0], v[1]}), b = gelu_pk((f32x2){v[2], v[3]}); return (f32x4){a.x, a.y, b.x, b.y}; }
__device__ __forceinline__ u32x2 pack4(f32x4 v) { u32x2 w; w.x = cvt_pk_bf16(v[0], v[1]); w.y = cvt_pk_bf16(v[2], v[3]); return w; }
__device__ __forceinline__ f32x4 unpack4(u32x2 w) { return (f32x4){bflo(w.x), bfhi(w.x), bflo(w.y), bfhi(w.y)}; }
__device__ __forceinline__ bf16x8 ldfrag(const LAS bf16_t* p) { return *(const LAS bf16x8*)p; }
__device__ __forceinline__ f32x4 zero4() { return (f32x4){0.f, 0.f, 0.f, 0.f}; }
__device__ __forceinline__ float row_rstd(const float* ssp, int row) {
    const f32x4* q = (const f32x4*)(ssp + (size_t)row * 16);
    const f32x4 a = q[0], b = q[1], c = q[2], d = q[3];
    const float t = (((a[0] + a[1]) + (a[2] + a[3])) + ((b[0] + b[1]) + (b[2] + b[3]))) + (((c[0] + c[1]) + (c[2] + c[3])) + ((d[0] + d[1]) + (d[2] + d[3])));
    return __builtin_amdgcn_rsqf(t * (1.0f / 1024.0f) + EPS);
}
__device__ __forceinline__ float row_rstd_q(const float* ssp, int row, int fq) {
    const f32x4 a = *(const f32x4*)(ssp + (size_t)row * 16 + 4 * fq);
    float t = (a[0] + a[1]) + (a[2] + a[3]);
    t += __shfl_xor(t, 16); t += __shfl_xor(t, 32);
    return __builtin_amdgcn_rsqf(t * (1.0f / 1024.0f) + EPS);
}
#define MFMA16(a, b, c) __builtin_amdgcn_mfma_f32_16x16x32_bf16((a), (b), (c), 0, 0, 0)

namespace pg8 {
constexpr int BM = 256, BK = 64, HALF = 128, HTB = HALF * BK * 2, STAGE_BYTES = 8 * HTB, NXCD = 8, WGM = 8;
__device__ __forceinline__ int lds_byte(int r, int c) { const int st = (r >> 4) * 2 + (c >> 5), rr = r & 15, cc = c & 31, ob = rr * 64 + cc * 2; return st * 1024 + (ob ^ (((ob >> 9) & 1) << 5)); }
__device__ __forceinline__ void stage_rc(int b, int& R, int& C) { const int st = b / 1024, sb = b % 1024, swz = sb ^ (((sb >> 9) & 1) << 5); R = (st >> 1) * 16 + swz / 64; C = (st & 1) * 32 + (swz % 64) / 2; }
__device__ __forceinline__ int perm32(int rho) { const int n = rho >> 4, i = rho & 15; return 8 * (i >> 2) + 4 * n + (i & 3); }
struct Unit { int pm, pn; };
struct Gemm { const bf16_t* A; const bf16_t* Bt; int M, N, K, lda; };
struct StaticOrder {
    int nM, nN, nwg, G, c;
    __device__ void init(int M, int N, int G_, int c_) { nM = M / BM; nN = N / BM; nwg = nM * nN; G = G_; c = c_; }
    __device__ bool next(int i, Unit& u) const {
        const long L = (long)i * G + c; if (L >= nwg) return false;
        int wgid = (int)L; { const int q = nwg / NXCD, r = nwg % NXCD, xcd = wgid % NXCD, off = wgid / NXCD; wgid = (xcd < r ? xcd * (q + 1) : r * (q + 1) + (xcd - r) * q) + off; }
        const int nig = WGM * nN, gid = wgid / nig, fm = gid * WGM, gsz = (nM - fm) < WGM ? (nM - fm) : WGM;
        u.pm = fm + ((wgid % nig) % gsz); u.pn = (wgid % nig) / gsz; return true;
    }
};

template <class Epi>
__device__ __forceinline__ void gemm_phase(LAS unsigned char* lds, const Gemm g, const StaticOrder& S, const Epi& E) {
    const int tid = fresh_tid(), wid = __builtin_amdgcn_readfirstlane(tid >> 6), lane = tid & 63, wr = wid >> 2, wc = wid & 3, fr = lane & 15, fq = lane >> 4;
    const int K = g.K, nt = K / BK;
    unsigned voffA[2], voffB[2];
#pragma unroll
    for (int i = 0; i < 2; ++i) { int R, C; stage_rc(tid * 16 + i * 8192, R, C); const int Rb = Epi::PERM ? ((R & ~31) + perm32(R & 31)) : R;
        const int Ra = Epi::ROWSPLIT ? ((R >> 6) * 128 + (R & 63)) : R;
        voffA[i] = (unsigned)(Ra * g.lda + C) * 2u; voffB[i] = (unsigned)(Rb * K + C) * 2u; }
    const size_t kstep = (size_t)(BK * 2);
    const size_t hstepA = (size_t)(Epi::ROWSPLIT ? 64 : HALF) * g.lda * 2, hstepB = (size_t)HALF * K * 2;
    const size_t tstepA = (size_t)BM * g.lda * 2, tstepB = 2 * hstepB;
    const unsigned ldsw = (unsigned)wid * 1024u;
    const int aoff = lds_byte(wr * 64 + fr, fq * 8), boff = lds_byte(wc * 32 + fr, fq * 8);
#define PG8_SA(b, h) (((b) * 2 + (h)) * HTB)
#define PG8_SB(b, h) ((4 + (b) * 2 + (h)) * HTB)
#define PG8_STAGE(bufoff, gbase, voff) do { _Pragma("unroll") for (int _i = 0; _i < 2; ++_i) \
        __builtin_amdgcn_global_load_lds((const unsigned*)((const char*)(gbase) + (voff)[_i]), (LAS unsigned*)(lds + (bufoff) + ldsw + _i * 8192), 16, 0, 0); } while (0)
#define PG8_LDA(dst, b, h) do { _Pragma("unroll") for (int m = 0; m < 4; ++m) _Pragma("unroll") for (int k = 0; k < 2; ++k) dst[m][k] = *(const LAS bf16x8*)(lds + PG8_SA(b, h) + aoff + m * 2048 + k * 1024); } while (0)
#define PG8_LDB(dst, b, h) do { _Pragma("unroll") for (int n = 0; n < 2; ++n) _Pragma("unroll") for (int k = 0; k < 2; ++k) dst[n][k] = *(const LAS bf16x8*)(lds + PG8_SB(b, h) + boff + n * 2048 + k * 1024); } while (0)
#define PG8_MMA(ai, bj, At, Bt) do { __builtin_amdgcn_s_setprio(1); _Pragma("unroll") for (int m = 0; m < 4; ++m) _Pragma("unroll") for (int n = 0; n < 2; ++n) _Pragma("unroll") for (int k = 0; k < 2; ++k) \
        acc[ai][bj][m][n] = __builtin_amdgcn_mfma_f32_16x16x32_bf16(Bt[n][k], At[m][k], acc[ai][bj][m][n], 0, 0, 0); __builtin_amdgcn_s_setprio(0); } while (0)
#define PG8_WAIT_V(n) asm volatile("s_waitcnt vmcnt(" #n ")" ::: "memory")
#define PG8_WAIT_L(n) asm volatile("s_waitcnt lgkmcnt(" #n ")" ::: "memory")
#define PG8_BAR __builtin_amdgcn_s_barrier()
#define PG8_SCHED __builtin_amdgcn_sched_barrier(0)
    Unit cur, nxt; int ui = 0;
    if (!S.next(0, cur)) return;
    f32x4 acc[2][2][4][2];
#pragma unroll
    for (int a = 0; a < 2; ++a)
#pragma unroll
        for (int b = 0; b < 2; ++b)
#pragma unroll
            for (int m = 0; m < 4; ++m)
#pragma unroll
                for (int n = 0; n < 2; ++n) acc[a][b][m][n] = (f32x4){0.f, 0.f, 0.f, 0.f};
    bf16x8 At[4][2], B0[2][2], B1[2][2];
    const char* cA = (const char*)g.A + (size_t)cur.pm * tstepA; const char* cB = (const char*)g.Bt + (size_t)cur.pn * tstepB;
    PG8_STAGE(PG8_SB(0, 0), cB, voffB); PG8_STAGE(PG8_SA(0, 0), cA, voffA); PG8_STAGE(PG8_SB(0, 1), cB + hstepB, voffB); PG8_STAGE(PG8_SA(0, 1), cA + hstepA, voffA);
    if (wr == 1) PG8_BAR;
    PG8_WAIT_V(4); PG8_BAR;
    PG8_STAGE(PG8_SB(1, 0), cB + kstep, voffB); PG8_STAGE(PG8_SA(1, 0), cA + kstep, voffA); PG8_STAGE(PG8_SB(1, 1), cB + hstepB + kstep, voffB);
    PG8_WAIT_V(6); PG8_BAR;
    for (;;) {
        const bool has_next = S.next(ui + 1, nxt);
        const char* nA = has_next ? (const char*)g.A + (size_t)nxt.pm * tstepA : cA; const char* nB = has_next ? (const char*)g.Bt + (size_t)nxt.pn * tstepB : cB;
        for (int t = 0; t < nt; t += 2) {
            const bool last = (t == nt - 2);
            const char* a1 = cA + (size_t)(t + 1) * kstep;
            const char* a2 = last ? nA : cA + (size_t)(t + 2) * kstep; const char* b2 = last ? nB : cB + (size_t)(t + 2) * kstep;
            const char* a3 = a2 + kstep; const char* b3 = b2 + kstep;
            PG8_LDB(B0, 0, 0); PG8_SCHED; PG8_LDA(At, 0, 0); PG8_STAGE(PG8_SA(1, 1), a1 + hstepA, voffA);
            PG8_WAIT_L(8); PG8_BAR; PG8_WAIT_L(0); PG8_MMA(0, 0, At, B0); PG8_BAR; PG8_SCHED;
            PG8_LDB(B1, 0, 1); PG8_STAGE(PG8_SB(0, 0), b2, voffB);
            PG8_BAR; PG8_WAIT_L(0); PG8_MMA(0, 1, At, B1); PG8_BAR;
            PG8_LDA(At, 0, 1); PG8_STAGE(PG8_SA(0, 0), a2, voffA);
            PG8_BAR; PG8_WAIT_L(0); PG8_MMA(1, 0, At, B0); PG8_BAR; PG8_SCHED;
            PG8_STAGE(PG8_SB(0, 1), b2 + hstepB, voffB);
            PG8_WAIT_V(6); PG8_BAR; PG8_MMA(1, 1, At, B1); PG8_BAR;
            PG8_LDB(B0, 1, 0); PG8_SCHED; PG8_LDA(At, 1, 0); PG8_STAGE(PG8_SA(0, 1), a2 + hstepA, voffA);
            PG8_WAIT_L(8); PG8_BAR; PG8_WAIT_L(0); PG8_MMA(0, 0, At, B0); PG8_BAR; PG8_SCHED;
            PG8_LDB(B1, 1, 1); PG8_STAGE(PG8_SB(1, 0), b3, voffB);
            PG8_BAR; PG8_WAIT_L(0); PG8_MMA(0, 1, At, B1); PG8_BAR;
            PG8_LDA(At, 1, 1); PG8_STAGE(PG8_SA(1, 0), a3, voffA);
            PG8_BAR; PG8_WAIT_L(0); PG8_MMA(1, 0, At, B0); PG8_BAR; PG8_SCHED;
            PG8_STAGE(PG8_SB(1, 1), b3 + hstepB, voffB);
            PG8_WAIT_V(6); PG8_BAR; PG8_MMA(1, 1, At, B1); PG8_BAR;
        }
        E(acc, cur, wr, wc, fr, fq);
        if (!has_next) break;
#pragma unroll
        for (int a = 0; a < 2; ++a)
#pragma unroll
            for (int b = 0; b < 2; ++b)
#pragma unroll
                for (int m = 0; m < 4; ++m)
#pragma unroll
                    for (int n = 0; n < 2; ++n) acc[a][b][m][n] = (f32x4){0.f, 0.f, 0.f, 0.f};
        cur = nxt; cA = nA; cB = nB; ++ui;
    }
    PG8_WAIT_V(0);
    if (wr == 0) PG8_BAR;
    PG8_BAR;
#undef PG8_SA
#undef PG8_SB
#undef PG8_STAGE
#undef PG8_LDA
#undef PG8_LDB
#undef PG8_MMA
#undef PG8_WAIT_V
#undef PG8_WAIT_L
#undef PG8_BAR
#undef PG8_SCHED
}
}
using pg8::Unit;
typedef f32x4 Acc[2][2][4][2];

struct EpiAB {
    static constexpr bool PERM = true, ROWSPLIT = false;
    bf16_t* PROJ; float* LF; const float* ssin; const float* lb;
    __device__ __forceinline__ void operator()(const Acc& acc, const Unit& u, int wr, int wc, int fr, int fq) const {
        const int seg = u.pn >> 1;
        const int row0 = u.pm * 256 + wr * 64 + fr, col0 = u.pn * 256 + wc * 32 + 8 * fq;
        float rsv[8];
#pragma unroll
        for (int g = 0; g < 8; ++g) rsv[g] = row_rstd_q(ssin, row0 + (g >> 2) * 128 + (g & 3) * 16, fq);
#pragma unroll
        for (int ai = 0; ai < 2; ++ai)
#pragma unroll
            for (int m = 0; m < 4; ++m) {
                const int row = row0 + ai * 128 + m * 16;
                const float rs = rsv[ai * 4 + m];
#pragma unroll
                for (int bj = 0; bj < 2; ++bj) {
                    const int col = col0 + bj * 128;
                    f32x4 v0 = acc[ai][bj][m][0] * rs, v1 = acc[ai][bj][m][1] * rs;
                    if (seg == 1) {
                        const f32x4 l0 = *(const f32x4*)(lb + (col - 512)), l1 = *(const f32x4*)(lb + (col - 512) + 4);
                        f32x4 o0, o1;
#pragma unroll
                        for (int j = 0; j < 4; ++j) { o0[j] = __logf(l0[j] + (1.0f - l0[j]) * sigmoidf_(v0[j])); o1[j] = __logf(l1[j] + (1.0f - l1[j]) * sigmoidf_(v1[j])); }
                        *(f32x4*)(LF + (size_t)row * 512 + (col - 512)) = o0;
                        *(f32x4*)(LF + (size_t)row * 512 + (col - 512) + 4) = o1;
                    } else {
                        if (seg == 0) {
#pragma unroll
                            for (int j = 0; j < 4; ++j) { v0[j] = v0[j] * sigmoidf_(v0[j]) * 0.08838834764831845f; v1[j] = v1[j] * sigmoidf_(v1[j]) * 0.08838834764831845f; }
                        } else if (seg == 3) {
#pragma unroll
                            for (int j = 0; j < 4; ++j) { v0[j] = v0[j] * sigmoidf_(v0[j]); v1[j] = v1[j] * sigmoidf_(v1[j]); }
                        }
                        const u32x2 w0 = pack4(v0), w1 = pack4(v1);
                        *(u32x4*)(PROJ + (size_t)row * 2560 + col) = (u32x4){w0.x, w0.y, w1.x, w1.y};
                    }
                }
            }
    }
};
struct EpiRes {
    static constexpr bool PERM = true, ROWSPLIT = false;
    bf16_t* Xb; float* ssout;
    __device__ __forceinline__ void operator()(const Acc& acc, const Unit& u, int wr, int wc, int fr, int fq) const {
        const int row0 = u.pm * 256 + wr * 64 + fr, col0 = u.pn * 256 + wc * 32 + 8 * fq;
        u32x4 bc[2], bn[2];
        { const bf16_t* b = Xb + (size_t)row0 * 1024 + col0; bc[0] = *(const u32x4*)b; bc[1] = *(const u32x4*)(b + 128); }
#pragma unroll
        for (int g = 0; g < 8; ++g) {
            const int row = row0 + (g >> 2) * 128 + (g & 3) * 16;
            if (g < 7) { const bf16_t* b = Xb + (size_t)(row0 + ((g + 1) >> 2) * 128 + ((g + 1) & 3) * 16) * 1024 + col0;
                bn[0] = *(const u32x4*)b; bn[1] = *(const u32x4*)(b + 128); }
            float s = 0.f;
#pragma unroll
            for (int bj = 0; bj < 2; ++bj) {
                const f32x4 x0 = (f32x4){bflo(bc[bj][0]), bfhi(bc[bj][0]), bflo(bc[bj][1]), bfhi(bc[bj][1])} + acc[g >> 2][bj][g & 3][0];
                const f32x4 x1 = (f32x4){bflo(bc[bj][2]), bfhi(bc[bj][2]), bflo(bc[bj][3]), bfhi(bc[bj][3])} + acc[g >> 2][bj][g & 3][1];
                const u32x2 w0 = pack4(x0), w1 = pack4(x1);
                *(u32x4*)(Xb + (size_t)row * 1024 + col0 + bj * 128) = (u32x4){w0.x, w0.y, w1.x, w1.y};
                s += ((x0[0] * x0[0] + x0[1] * x0[1]) + (x0[2] * x0[2] + x0[3] * x0[3])) + ((x1[0] * x1[0] + x1[1] * x1[1]) + (x1[2] * x1[2] + x1[3] * x1[3]));
            }
            s += __shfl_xor(s, 16); s += __shfl_xor(s, 32);
            if (fq == 0) ssout[(size_t)row * 16 + u.pn * 4 + wc] = s;
            bc[0] = bn[0]; bc[1] = bn[1];
        }
    }
};
struct EpiUV {
    static constexpr bool PERM = true, ROWSPLIT = false;
    bf16_t* UV; const float* ssin; float* vst;
    __device__ __forceinline__ void operator()(const Acc& acc, const Unit& u, int wr, int wc, int fr, int fq) const {
        const bool isv = u.pn >= 8;
        const int row0 = u.pm * 256 + wr * 64 + fr, col0 = u.pn * 256 + wc * 32 + 8 * fq;
        float rsv[8];
#pragma unroll
        for (int g = 0; g < 8; ++g) rsv[g] = row_rstd_q(ssin, row0 + (g >> 2) * 128 + (g & 3) * 16, fq);
#pragma unroll
        for (int ai = 0; ai < 2; ++ai)
#pragma unroll
            for (int m = 0; m < 4; ++m) {
                const int row = row0 + ai * 128 + m * 16;
                const float rs = rsv[ai * 4 + m];
                float s1 = 0.f, s2 = 0.f;
#pragma unroll
                for (int bj = 0; bj < 2; ++bj) {
                    const int col = col0 + bj * 128;
                    const f32x4 z0 = gelu4(acc[ai][bj][m][0] * rs), z1 = gelu4(acc[ai][bj][m][1] * rs);
                    const u32x2 w0 = pack4(z0), w1 = pack4(z1);
                    *(u32x4*)(UV + (size_t)row * 4096 + col) = (u32x4){w0.x, w0.y, w1.x, w1.y};
                    s1 += ((z0[0] + z0[1]) + (z0[2] + z0[3])) + ((z1[0] + z1[1]) + (z1[2] + z1[3]));
                    s2 += ((z0[0] * z0[0] + z0[1] * z0[1]) + (z0[2] * z0[2] + z0[3] * z0[3])) + ((z1[0] * z1[0] + z1[1] * z1[1]) + (z1[2] * z1[2] + z1[3] * z1[3]));
                }
                if (isv) {
                    s1 += __shfl_xor(s1, 16); s1 += __shfl_xor(s1, 32);
                    s2 += __shfl_xor(s2, 16); s2 += __shfl_xor(s2, 32);
                    if (fq == 0) { f32x2 pr = {s1, s2}; *(f32x2*)(vst + (size_t)row * 64 + ((u.pn - 8) * 4 + wc) * 2) = pr; }
                }
            }
    }
};
struct EpiFF1 {
    static constexpr bool PERM = true, ROWSPLIT = false;
    bf16_t* BIG; const float* ssin;
    __device__ __forceinline__ void operator()(const Acc& acc, const Unit& u, int wr, int wc, int fr, int fq) const {
        const int row0 = u.pm * 256 + wr * 64 + fr, col0 = u.pn * 256 + wc * 32 + 8 * fq;
        float rsv[8];
#pragma unroll
        for (int g = 0; g < 8; ++g) rsv[g] = row_rstd_q(ssin, row0 + (g >> 2) * 128 + (g & 3) * 16, fq);
#pragma unroll
        for (int ai = 0; ai < 2; ++ai)
#pragma unroll
            for (int m = 0; m < 4; ++m) {
                const int row = row0 + ai * 128 + m * 16;
                const float rs = rsv[ai * 4 + m];
#pragma unroll
                for (int bj = 0; bj < 2; ++bj) {
                    const u32x2 w0 = pack4(acc[ai][bj][m][0] * rs), w1 = pack4(acc[ai][bj][m][1] * rs);
                    *(u32x4*)(BIG + (size_t)row * 5632 + col0 + bj * 128) = (u32x4){w0.x, w0.y, w1.x, w1.y};
                }
            }
    }
};


struct EpiFF2 {
    static constexpr bool PERM = true, ROWSPLIT = true;
    bf16_t* Y; float* EDGE; const float* ssin; const float* cw; const float* cb;
    __device__ __forceinline__ void operator()(const Acc& acc, const Unit& u, int wr, int wc, int fr, int fq) const {
        const int cl = wc * 32 + 8 * fq, c = u.pn * 128 + cl;
        const int row0 = u.pm * 256 + wr * 128 + fr;
        const unsigned ybase = (unsigned)row0 * 2816u + (unsigned)c;
        float rsv[8];
#pragma unroll
        for (int g = 0; g < 8; ++g) rsv[g] = row_rstd_q(ssin, row0 + (g >> 2) * 64 + (g & 3) * 16, fq);
#pragma unroll
        for (int h = 0; h < 2; ++h) {
            const f32x4 w0 = *(const f32x4*)(cw + c + 4 * h), w1 = *(const f32x4*)(cw + 2816 + c + 4 * h), w2 = *(const f32x4*)(cw + 5632 + c + 4 * h), bs = *(const f32x4*)(cb + c + 4 * h);
            f32x4 prev = (f32x4){0.f, 0.f, 0.f, 0.f};
#pragma unroll
            for (int ai = 0; ai < 2; ++ai)
#pragma unroll
                for (int m = 0; m < 4; ++m) {
                    const float rs = rsv[ai * 4 + m];
                    const f32x4 cur = acc[ai][0][m][h] * rs, gt = acc[ai][1][m][h] * rs;
                    f32x4 p1, p2;
#pragma unroll
                    for (int j = 0; j < 4; ++j) {
                        const float m1 = (fr == 15) ? prev[j] : cur[j], m2 = (fr >= 14) ? prev[j] : cur[j];
                        p1[j] = __builtin_bit_cast(float, __builtin_amdgcn_mov_dpp(__builtin_bit_cast(int, m1), 0x121, 0xf, 0xf, true));
                        p2[j] = __builtin_bit_cast(float, __builtin_amdgcn_mov_dpp(__builtin_bit_cast(int, m2), 0x122, 0xf, 0xf, true));
                    }
                    const f32x4 ge = gelu4(bs + w0 * p2 + w1 * p1 + w2 * cur);
                    *(u32x2*)(Y + (ybase + (unsigned)((ai * 64 + m * 16) * 2816 + 4 * h))) = pack4(ge * gt);
                    prev = cur;
                }
        }
        if (fr < 2) {
            const f32x4 a0 = acc[0][0][0][0] * rsv[0], a1 = acc[0][0][0][1] * rsv[0], g0 = acc[0][1][0][0] * rsv[0], g1 = acc[0][1][0][1] * rsv[0];
            float* ep = EDGE + ((size_t)u.pm * 12 + wr * 6 + fr) * 2816 + c; *(f32x4*)ep = a0; *(f32x4*)(ep + 4) = a1;
            float* gp = EDGE + ((size_t)u.pm * 12 + wr * 6 + 2 + fr) * 2816 + c; *(f32x4*)gp = g0; *(f32x4*)(gp + 4) = g1;
        }
        if (fr >= 14) {
            const f32x4 a0 = acc[1][0][3][0] * rsv[7], a1 = acc[1][0][3][1] * rsv[7];
            float* ep = EDGE + ((size_t)u.pm * 12 + wr * 6 + 4 + (fr - 14)) * 2816 + c; *(f32x4*)ep = a0; *(f32x4*)(ep + 4) = a1;
        }
    }
};
struct SEpiFF2 {
    bf16_t* SBUF; const float* ssin;
    __device__ __forceinline__ void operator()(f32x4 v, int row, int col, int sl, int l16) const {
        const int orig = ((col >> 7) & 1) * 2816 + (col >> 8) * 128 + (col & 127);
        *(u32x2*)(SBUF + (size_t)(row - MP) * 5632 + orig) = pack4(v * row_rstd(ssin, row));
    }
};

constexpr int SPS = 68;
template <class Epi>
__device__ __forceinline__ void sample_gemm(LAS unsigned char* lds, const bf16_t* A, int lda, const bf16_t* Bt, int K, int N, const Epi& E) {
    const int tid = fresh_tid(), lane = tid & 63, w = tid >> 6, fr = lane & 15, fq = lane >> 4;
    LAS float* P = (LAS float*)lds;
    const int nslab = N >> 6, nitems = nslab * 8, kw = K >> 3, kbeg = w * kw;
    for (int it = blockIdx.x; it < nitems; it += gridDim.x) {
        const int sl = it >> 3, r0 = (it & 7) * 32, n0 = sl * 64;
        f32x4 acc[2][4];
#pragma unroll
        for (int i = 0; i < 2; ++i)
#pragma unroll
            for (int j = 0; j < 4; ++j) acc[i][j] = (f32x4){0.f, 0.f, 0.f, 0.f};
        const bf16_t* ap = A + (size_t)(r0 + fr) * lda + kbeg + 8 * fq;
        const bf16_t* bp = Bt + (size_t)(n0 + fr) * K + kbeg + 8 * fq;
#pragma unroll 4
        for (int ks = 0; ks < kw; ks += 32) {
            const bf16x8 a0 = *(const bf16x8*)(ap + ks), a1 = *(const bf16x8*)(ap + (size_t)16 * lda + ks);
            bf16x8 b[4];
#pragma unroll
            for (int j = 0; j < 4; ++j) b[j] = *(const bf16x8*)(bp + (size_t)j * 16 * K + ks);
#pragma unroll
            for (int j = 0; j < 4; ++j) { acc[0][j] = MFMA16(b[j], a0, acc[0][j]); acc[1][j] = MFMA16(b[j], a1, acc[1][j]); }
        }
#pragma unroll
        for (int i = 0; i < 2; ++i)
#pragma unroll
            for (int j = 0; j < 4; ++j) *(LAS f32x4*)(P + (w * 32 + 16 * i + fr) * SPS + 16 * j + 4 * fq) = acc[i][j];
        __syncthreads();
        const int r = tid >> 4, c4 = (tid & 15) * 4;
        f32x4 v = *(const LAS f32x4*)(P + r * SPS + c4);
#pragma unroll
        for (int ww = 1; ww < 8; ++ww) v += *(const LAS f32x4*)(P + (ww * 32 + r) * SPS + c4);
        E(v, MP + r0 + r, n0 + c4, sl, tid & 15);
        __syncthreads();
    }
}
struct SEpiAB {
    bf16_t* PROJ; float* LF; const float* ssin; const float* lb;
    __device__ __forceinline__ void operator()(f32x4 v, int row, int col, int sl, int l16) const {
        const int seg = col >> 9;
        v = v * row_rstd(ssin, row);
        if (seg == 1) {
            const f32x4 l = *(const f32x4*)(lb + (col - 512));
            f32x4 o;
#pragma unroll
            for (int q = 0; q < 4; ++q) { const float f = l[q] + (1.0f - l[q]) * sigmoidf_(v[q]); o[q] = __logf(f); }
            *(f32x4*)(LF + (size_t)row * 512 + (col - 512)) = o;
        } else {
            if (seg == 0) {
#pragma unroll
                for (int q = 0; q < 4; ++q) v[q] = v[q] * sigmoidf_(v[q]) * 0.08838834764831845f;
            } else if (seg == 3) {
#pragma unroll
                for (int q = 0; q < 4; ++q) v[q] = v[q] * sigmoidf_(v[q]);
            }
            *(u32x2*)(PROJ + (size_t)row * 2560 + col) = pack4(v);
        }
    }
};
struct SEpiRes {
    bf16_t* Xb; float* ssout;
    __device__ __forceinline__ void operator()(f32x4 v, int row, int col, int sl, int l16) const {
        bf16_t* xp = Xb + (size_t)row * 1024 + col;
        const f32x4 x = unpack4(*(const u32x2*)xp) + v;
        *(u32x2*)xp = pack4(x);
        float s = (x[0] * x[0] + x[1] * x[1]) + (x[2] * x[2] + x[3] * x[3]);
        s += __shfl_xor(s, 1); s += __shfl_xor(s, 2); s += __shfl_xor(s, 4); s += __shfl_xor(s, 8);
        if (l16 == 0) ssout[(size_t)row * 16 + sl] = s;
    }
};
struct SEpiUV {
    bf16_t* UV; const float* ssin; float* vst;
    __device__ __forceinline__ void operator()(f32x4 v, int row, int col, int sl, int l16) const {
        const f32x4 z = gelu4(v * row_rstd(ssin, row));
        *(u32x2*)(UV + (size_t)row * 4096 + col) = pack4(z);
        if (col >= 2048) {
            float s1 = (z[0] + z[1]) + (z[2] + z[3]), s2 = (z[0] * z[0] + z[1] * z[1]) + (z[2] * z[2] + z[3] * z[3]);
            s1 += __shfl_xor(s1, 1); s1 += __shfl_xor(s1, 2); s1 += __shfl_xor(s1, 4); s1 += __shfl_xor(s1, 8);
            s2 += __shfl_xor(s2, 1); s2 += __shfl_xor(s2, 2); s2 += __shfl_xor(s2, 4); s2 += __shfl_xor(s2, 8);
            if (l16 == 0) { f32x2 pr = {s1, s2}; *(f32x2*)(vst + (size_t)row * 64 + (sl - 32) * 2) = pr; }
        }
    }
};
struct SEpiFF1 {
    bf16_t* BIG; const float* ssin;
    __device__ __forceinline__ void operator()(f32x4 v, int row, int col, int sl, int l16) const {
        *(u32x2*)(BIG + (size_t)row * 5632 + col) = pack4(v * row_rstd(ssin, row));
    }
};

__device__ __forceinline__ void convT(LAS unsigned char* lds, const float* W, int K, int N, const float* gain, bf16_t* Bt, int ldb, int rot, bool ffperm = false) {
    LAS float* tile = (LAS float*)lds;
    const int tid = fresh_tid(), nb = gridDim.x;
    const int ntn = N >> 7, ntiles = (K >> 6) * ntn;
    const int start = (int)((blockIdx.x + nb - (rot % nb)) % nb);
    const int li = tid >> 5, c4 = (tid & 31) * 4;
    f32x4 v[4]; float gg[4];
    if (start < ntiles) { const int k0 = (start / ntn) << 6, n0 = (start % ntn) << 7;
#pragma unroll
        for (int ps = 0; ps < 4; ++ps) { v[ps] = *(const f32x4*)(W + (size_t)(k0 + ps * 16 + li) * N + n0 + c4); gg[ps] = gain ? gain[k0 + ps * 16 + li] : 1.0f; } }
    for (int t = start; t < ntiles; t += nb) {
        const int k0 = (t / ntn) << 6, n0 = (t % ntn) << 7;
#pragma unroll
        for (int ps = 0; ps < 4; ++ps) {
            const int i = ps * 16 + li;
#pragma unroll
            for (int j = 0; j < 4; ++j) tile[i * 129 + c4 + j] = v[ps][j] * gg[ps];
        }
        __syncthreads();
        if (t + nb < ntiles) { const int k1 = ((t + nb) / ntn) << 6, n1 = ((t + nb) % ntn) << 7;
#pragma unroll
            for (int ps = 0; ps < 4; ++ps) { v[ps] = *(const f32x4*)(W + (size_t)(k1 + ps * 16 + li) * N + n1 + c4); gg[ps] = gain ? gain[k1 + ps * 16 + li] : 1.0f; } }
        const int n = tid >> 2, ks = (tid & 3) * 16;
        unsigned w[8];
#pragma unroll
        for (int j = 0; j < 8; ++j) w[j] = cvt_pk_bf16(tile[(ks + 2 * j) * 129 + n], tile[(ks + 2 * j + 1) * 129 + n]);
        const int n0p = ffperm ? ((n0 < 2816) ? 2 * n0 : 2 * (n0 - 2816) + 128) : n0;
        bf16_t* dst = Bt + (size_t)(n0p + n) * ldb + k0 + ks;
        *(u32x4*)dst = (u32x4){w[0], w[1], w[2], w[3]};
        *(u32x4*)(dst + 8) = (u32x4){w[4], w[5], w[6], w[7]};
        __syncthreads();
    }
}
__device__ __forceinline__ void fold_pool(LAS unsigned char* lds, const float* pool_w, const float* pool_scale, const float* w_out, bf16_t* Bt2, int rot) {
    LAS float* pw = (LAS float*)lds;
    const int tid = fresh_tid(), nb = gridDim.x;
    const int start = (int)((blockIdx.x + nb - (rot % nb)) % nb);
    for (int item = start; item < 128; item += nb) {
        const int g = item >> 5, d0 = (item & 31) * 32;
        for (int i = 0; i < 32; ++i) { const int idx = tid + i * 512, c = idx >> 7, e = idx & 127; pw[c * 129 + e] = pool_w[(size_t)(g * 128 + c) * 128 + e] * pool_scale[g * 128 + e]; }
        __syncthreads();
        const int c = tid & 127, dbase = d0 + (tid >> 7) * 8;
        float a0 = 0.f, a1 = 0.f, a2 = 0.f, a3 = 0.f, a4 = 0.f, a5 = 0.f, a6 = 0.f, a7 = 0.f;
        for (int e = 0; e < 128; ++e) {
            const float a = pw[c * 129 + e];
            const float* wrp = w_out + (size_t)(512 + g * 128 + e) * 1024 + dbase;
            const f32x4 w0 = *(const f32x4*)wrp, w1 = *(const f32x4*)(wrp + 4);
            a0 += a * w0[0]; a1 += a * w0[1]; a2 += a * w0[2]; a3 += a * w0[3];
            a4 += a * w1[0]; a5 += a * w1[1]; a6 += a * w1[2]; a7 += a * w1[3];
        }
        bf16_t* dst = Bt2 + (size_t)dbase * 1024 + 512 + g * 128 + c;
        dst[0] = f2bf(a0); dst[1024] = f2bf(a1); dst[2048] = f2bf(a2); dst[3072] = f2bf(a3);
        dst[4096] = f2bf(a4); dst[5120] = f2bf(a5); dst[6144] = f2bf(a6); dst[7168] = f2bf(a7);
        __syncthreads();
    }
}
__device__ __forceinline__ void prep_layer(const Params& p, LAS unsigned char* lds, int l) {
    bf16_t* slot = (bf16_t*)(p.ws + WS_W0 + (size_t)(l & 1) * SLOT_BYTES);
    const int h = l >> 1;
    size_t ffo_in, ffo_out;
    if ((l & 1) == 0) {
        convT(lds, p.in[9] + (size_t)h * 1024 * 2560, 1024, 2560, p.in[5] + l * 1024, slot, 1024, 0);
        convT(lds, p.in[13] + (size_t)h * 1024 * 1024, 512, 1024, nullptr, slot + 2621440, 1024, 320);
        fold_pool(lds, p.in[11] + (size_t)h * 4 * 128 * 128, p.in[12] + h * 512, p.in[13] + (size_t)h * 1024 * 1024, slot + 2621440, 384);
        ffo_in = 3670016; ffo_out = 9437184;
    } else {
        convT(lds, p.in[14] + (size_t)h * 1024 * 4096, 1024, 4096, p.in[5] + l * 1024, slot, 1024, 0);
        convT(lds, p.in[19] + (size_t)h * 2048 * 1024, 2048, 1024, nullptr, slot + 4194304, 2048, 0);
        ffo_in = 6291456; ffo_out = 12058624;
    }
    convT(lds, p.in[20] + (size_t)l * 1024 * 5632, 1024, 5632, p.in[6] + l * 1024, slot + ffo_in, 1024, 0, true);
    convT(lds, p.in[23] + (size_t)l * 2816 * 1024, 2816, 1024, nullptr, slot + ffo_out, 2816, 192);
}

__device__ __forceinline__ void phase0(const Params& p, LAS unsigned char* lds) {
    const int tid = fresh_tid(), bid = blockIdx.x, nb = gridDim.x;
    float* ss = (float*)(p.ws + WS_SS);
    if (bid == 0) {
        float* lb = (float*)(p.ws + WS_LB); const float* lg = p.in[8];
        for (int k = tid; k < 512; k += NTHR) { const float l0 = lg[k], l1 = lg[512 + k], mx = fmaxf(l0, l1), e0 = expf(l0 - mx), e1 = expf(l1 - mx); lb[k] = 0.f; lb[512 + k] = e1 / (e0 + e1); }
    }
    { bf16_t* Xb = (bf16_t*)(p.ws + WS_XB); const int wave = tid >> 6, lane = tid & 63;
#pragma unroll 2
      for (int row = bid * 8 + wave; row < MA; row += nb * 8) {
          const float* src = row < MP ? p.in[0] + (size_t)row * 1024 : p.in[1] + (size_t)(row - MP) * 1024;
          float s = 0.f;
#pragma unroll
          for (int j = 0; j < 4; ++j) { const f32x4 v = *(const f32x4*)(src + (j * 64 + lane) * 4); s += (v[0] * v[0] + v[1] * v[1]) + (v[2] * v[2] + v[3] * v[3]);
              *(u32x2*)(Xb + (size_t)row * 1024 + (j * 64 + lane) * 4) = pack4(v); }
          for (int o = 32; o >= 1; o >>= 1) s += __shfl_xor(s, o);
          if (lane < 16) ss[(size_t)row * 16 + lane] = (lane == 0) ? s : 0.f;
      } }
    prep_layer(p, lds, 0);
    prep_layer(p, lds, 1);
}

constexpr int BCS = 132;
constexpr int TS = 72;
constexpr int QS = 136;
constexpr int L_BC = 0;
constexpr int L_TOT = 33792;
constexpr int L_KT = 35840;
constexpr int L_VT = 54272;
constexpr int L_QT = 72704;
constexpr int L_K2 = 90112;
constexpr int L_QH = 107520;
constexpr int L_P = 124928;
constexpr int L_SSQ = 35840;

__device__ __forceinline__ void chunk_cumsum(LAS unsigned char* lds, const float* LF, int row0, int h) {
    LAS float* Bc = (LAS float*)(lds + L_BC); LAS float* tot = (LAS float*)(lds + L_TOT);
    const int tid = fresh_tid(), k = tid & 127, part = tid >> 7;
    const float* src = LF + (size_t)(row0 + part * 16) * 512 + h * 128 + k;
    float v[16];
#pragma unroll
    for (int i = 0; i < 16; ++i) v[i] = src[(size_t)i * 512];
    float c = 0.f;
#pragma unroll
    for (int i = 0; i < 16; ++i) { c += v[i]; v[i] = c; }
    tot[part * 128 + k] = c;
    __syncthreads();
    float pre = 0.f;
    if (part > 0) pre += tot[k];
    if (part > 1) pre += tot[128 + k];
    if (part > 2) pre += tot[256 + k];
#pragma unroll
    for (int i = 0; i < 16; ++i) Bc[(part * 16 + i) * BCS + k] = v[i] + pre;
    __syncthreads();
}

__device__ __forceinline__ void hgrn_pass1(const Params& p, LAS unsigned char* lds, int item) {
    const int tid = fresh_tid(), lane = tid & 63, w = tid >> 6;
    const int bh = item >> 6, c = item & 63, b = bh >> 2, h = bh & 3, row0 = b * 4096 + c * 64;
    const bf16_t* PROJ = (const bf16_t*)(p.ws + WS_R + R_PROJ); const float* LF = (const float*)(p.ws + WS_R + R_LF);
    bf16_t* ST = (bf16_t*)(p.ws + WS_R + R_ST); float* DEC = (float*)(p.ws + WS_R + R_DEC);
    LAS float* Bc = (LAS float*)(lds + L_BC); LAS bf16_t* KT = (LAS bf16_t*)(lds + L_KT); LAS bf16_t* VT = (LAS bf16_t*)(lds + L_VT);
    const int s0 = (tid >> 4) * 2, k0 = (tid & 15) * 8;
    const float* lfp = LF + (size_t)(row0 + s0) * 512 + h * 128 + k0;
    const f32x4 la0 = *(const f32x4*)lfp, la1 = *(const f32x4*)(lfp + 4), lb0 = *(const f32x4*)(lfp + 512), lb1 = *(const f32x4*)(lfp + 516);
    const u32x4 va = *(const u32x4*)(PROJ + (size_t)(row0 + s0) * 2560 + 1024 + h * 128 + k0);
    const u32x4 vb = *(const u32x4*)(PROJ + (size_t)(row0 + s0 + 1) * 2560 + 1024 + h * 128 + k0);
    chunk_cumsum(lds, LF, row0, h);
    {
        const f32x4 ba0 = *(const LAS f32x4*)(Bc + s0 * BCS + k0), ba1 = *(const LAS f32x4*)(Bc + s0 * BCS + k0 + 4);
        const f32x4 bb0 = *(const LAS f32x4*)(Bc + (s0 + 1) * BCS + k0), bb1 = *(const LAS f32x4*)(Bc + (s0 + 1) * BCS + k0 + 4);
        const f32x4 e0 = *(const LAS f32x4*)(Bc + 63 * BCS + k0), e1 = *(const LAS f32x4*)(Bc + 63 * BCS + k0 + 4);
#pragma unroll
        for (int j = 0; j < 4; ++j) {
            const float ka0 = (1.0f - __expf(la0[j])) * __expf(e0[j] - ba0[j]), kb0 = (1.0f - __expf(lb0[j])) * __expf(e0[j] - bb0[j]);
            const float ka1 = (1.0f - __expf(la1[j])) * __expf(e1[j] - ba1[j]), kb1 = (1.0f - __expf(lb1[j])) * __expf(e1[j] - bb1[j]);
            *(LAS unsigned*)(KT + (k0 + j) * TS + s0) = cvt_pk_bf16(ka0, kb0);
            *(LAS unsigned*)(KT + (k0 + 4 + j) * TS + s0) = cvt_pk_bf16(ka1, kb1);
            *(LAS unsigned*)(VT + (k0 + 2 * j) * TS + s0) = (va[j] & 0xffffu) | (vb[j] << 16);
            *(LAS unsigned*)(VT + (k0 + 2 * j + 1) * TS + s0) = (va[j] >> 16) | (vb[j] & 0xffff0000u);
        }
    }
    if (tid < 128) DEC[(size_t)item * 128 + tid] = __expf(Bc[63 * BCS + tid]);
    __syncthreads();
    f32x4 acc[8];
#pragma unroll
    for (int j = 0; j < 8; ++j) acc[j] = zero4();
    const int fr = lane & 15, fq = lane >> 4;
#pragma unroll
    for (int kk = 0; kk < 2; ++kk) {
        const bf16x8 a = ldfrag(KT + (16 * w + fr) * TS + 8 * fq + 32 * kk);
#pragma unroll
        for (int jt = 0; jt < 8; ++jt) { const bf16x8 bb = ldfrag(VT + (16 * jt + fr) * TS + 8 * fq + 32 * kk); acc[jt] = MFMA16(a, bb, acc[jt]); }
    }
    bf16_t* dst = ST + (size_t)item * 16384;
#ifdef P1_DBG
#pragma unroll
    for (int jt = 0; jt < 8; ++jt) { const unsigned xk = *(const LAS unsigned*)(KT + (16 * w + fr) * TS + 2 * (jt * 4 + fq)), xv = *(const LAS unsigned*)(VT + (16 * w + fr) * TS + 2 * (jt * 4 + fq));
        acc[jt] = (f32x4){bflo(xk), bfhi(xk), bflo(xv), bfhi(xv)}; }
#endif
#pragma unroll
    for (int jt = 0; jt < 8; ++jt) *(u32x2*)(dst + (16 * jt + fr) * 128 + 16 * w + 4 * fq) = pack4(acc[jt]);
    __syncthreads();
}

__device__ __forceinline__ void hgrn_pass2(const Params& p, int e) {
    bf16_t* ST = (bf16_t*)(p.ws + WS_R + R_ST); const float* DEC = (const float*)(p.ws + WS_R + R_DEC);
    float* outp = p.out + O_HP + (size_t)e * 8 * 4 * 16384;
    for (int g = blockIdx.x * NTHR + fresh_tid(); g < 32 * 4096; g += gridDim.x * NTHR) {
        const int bh = g >> 12, rem = g & 4095, v = rem >> 5, kq = rem & 31;
        f32x4 s = (f32x4){0.f, 0.f, 0.f, 0.f};
        bf16_t* ptr = ST + (size_t)bh * 64 * 16384 + v * 128 + kq * 4;
        const float* dp = DEC + (size_t)bh * 64 * 128 + kq * 4;
#pragma unroll 16
        for (int c = 0; c < 64; ++c) {
            const u32x2 raw = *(const u32x2*)(ptr + (size_t)c * 16384);
            const f32x4 d = *(const f32x4*)(dp + c * 128);
            *(u32x2*)(ptr + (size_t)c * 16384) = pack4(s);
            s = d * s + unpack4(raw);
        }
        float* o = outp + (size_t)bh * 16384 + (kq * 4) * 128 + v;
        o[0] = s[0]; o[128] = s[1]; o[256] = s[2]; o[384] = s[3];
    }
}

__device__ __forceinline__ void hgrn_pass3(const Params& p, LAS unsigned char* lds, int item, int e) {
    const int tid = fresh_tid(), lane = tid & 63, w = tid >> 6, fr = lane & 15, fq = lane >> 4;
    const int bh = item >> 6, c = item & 63, b = bh >> 2, h = bh & 3, row0 = b * 4096 + c * 64;
    const bf16_t* PROJ = (const bf16_t*)(p.ws + WS_R + R_PROJ); const float* LF = (const float*)(p.ws + WS_R + R_LF);
    const bf16_t* ST = (const bf16_t*)(p.ws + WS_R + R_ST) + (size_t)item * 16384;
    bf16_t* A2 = (bf16_t*)(p.ws + WS_R + R_A2);
    LAS float* Bc = (LAS float*)(lds + L_BC); LAS bf16_t* VT = (LAS bf16_t*)(lds + L_VT);
    LAS bf16_t* QT = (LAS bf16_t*)(lds + L_QT); LAS bf16_t* K2 = (LAS bf16_t*)(lds + L_K2); LAS bf16_t* QH = (LAS bf16_t*)(lds + L_QH);
    LAS bf16_t* P = (LAS bf16_t*)(lds + L_P); LAS float* SSQ = (LAS float*)(lds + L_SSQ);
    bf16x8 sfr[4];
#pragma unroll
    for (int kk = 0; kk < 4; ++kk) sfr[kk] = *(const bf16x8*)(ST + (16 * w + fr) * 128 + 8 * fq + 32 * kk);
    f32x4 gl0[2], gl1[2]; u32x4 gqq[2], gvv[2];
#pragma unroll
    for (int it = 0; it < 2; ++it) {
        const int idx = tid + it * 512, s = idx >> 4, k0 = (idx & 15) * 8;
        const float* lfp = LF + (size_t)(row0 + s) * 512 + h * 128 + k0;
        gl0[it] = *(const f32x4*)lfp; gl1[it] = *(const f32x4*)(lfp + 4);
        gqq[it] = *(const u32x4*)(PROJ + (size_t)(row0 + s) * 2560 + h * 128 + k0);
        gvv[it] = *(const u32x4*)(PROJ + (size_t)(row0 + s) * 2560 + 1024 + h * 128 + k0);
    }
    u32x2 gsg[4];
#pragma unroll
    for (int tt = 0; tt < 4; ++tt) gsg[tt] = *(const u32x2*)(PROJ + (size_t)(row0 + 16 * tt + fr) * 2560 + 1536 + h * 128 + 16 * w + 4 * fq);
    chunk_cumsum(lds, LF, row0, h);
#pragma unroll
    for (int it = 0; it < 2; ++it) {
        const int idx = tid + it * 512, s = idx >> 4, k0 = (idx & 15) * 8;
        const f32x4 l0 = gl0[it], l1 = gl1[it];
        const f32x4 b0 = *(const LAS f32x4*)(Bc + s * BCS + k0), b1 = *(const LAS f32x4*)(Bc + s * BCS + k0 + 4);
        const f32x4 r0 = *(const LAS f32x4*)(Bc + 31 * BCS + k0), r1 = *(const LAS f32x4*)(Bc + 31 * BCS + k0 + 4);
        const u32x4 qq = gqq[it];
        const u32x4 vv = gvv[it];
        float q[8] = {bflo(qq[0]), bfhi(qq[0]), bflo(qq[1]), bfhi(qq[1]), bflo(qq[2]), bfhi(qq[2]), bflo(qq[3]), bfhi(qq[3])};
        float bb[8] = {b0[0], b0[1], b0[2], b0[3], b1[0], b1[1], b1[2], b1[3]};
        float rr[8] = {r0[0], r0[1], r0[2], r0[3], r1[0], r1[1], r1[2], r1[3]};
        float ll[8] = {l0[0], l0[1], l0[2], l0[3], l1[0], l1[1], l1[2], l1[3]};
        float qt[8], kt[8], qh[8];
#pragma unroll
        for (int j = 0; j < 8; ++j) {
            const float d = bb[j] - rr[j];
            qt[j] = q[j] * __expf(clampe(d));
            kt[j] = (1.0f - __expf(ll[j])) * __expf(clampe(-d));
            qh[j] = q[j] * __expf(bb[j]);
        }
        *(LAS u32x4*)(QT + s * QS + k0) = (u32x4){cvt_pk_bf16(qt[0], qt[1]), cvt_pk_bf16(qt[2], qt[3]), cvt_pk_bf16(qt[4], qt[5]), cvt_pk_bf16(qt[6], qt[7])};
        *(LAS u32x4*)(K2 + s * QS + k0) = (u32x4){cvt_pk_bf16(kt[0], kt[1]), cvt_pk_bf16(kt[2], kt[3]), cvt_pk_bf16(kt[4], kt[5]), cvt_pk_bf16(kt[6], kt[7])};
        *(LAS u32x4*)(QH + s * QS + k0) = (u32x4){cvt_pk_bf16(qh[0], qh[1]), cvt_pk_bf16(qh[2], qh[3]), cvt_pk_bf16(qh[4], qh[5]), cvt_pk_bf16(qh[6], qh[7])};
        VT[(k0 + 0) * TS + s] = (bf16_t)(vv[0] & 0xffff); VT[(k0 + 1) * TS + s] = (bf16_t)(vv[0] >> 16);
        VT[(k0 + 2) * TS + s] = (bf16_t)(vv[1] & 0xffff); VT[(k0 + 3) * TS + s] = (bf16_t)(vv[1] >> 16);
        VT[(k0 + 4) * TS + s] = (bf16_t)(vv[2] & 0xffff); VT[(k0 + 5) * TS + s] = (bf16_t)(vv[2] >> 16);
        VT[(k0 + 6) * TS + s] = (bf16_t)(vv[3] & 0xffff); VT[(k0 + 7) * TS + s] = (bf16_t)(vv[3] >> 16);
    }
    __syncthreads();
#pragma unroll
    for (int ti = 0; ti < 2; ++ti) {
        const int idx = w + ti * 8, tt = idx >> 2, st = idx & 3;
        f32x4 acc = zero4();
        if (st <= tt) {
#pragma unroll
            for (int kk = 0; kk < 4; ++kk) {
                const bf16x8 a = ldfrag(K2 + (16 * st + fr) * QS + 8 * fq + 32 * kk);
                const bf16x8 bq = ldfrag(QT + (16 * tt + fr) * QS + 8 * fq + 32 * kk);
                acc = MFMA16(a, bq, acc);
            }
            const int t = 16 * tt + fr, s0 = 16 * st + 4 * fq;
#pragma unroll
            for (int j = 0; j < 4; ++j) if (s0 + j > t) acc[j] = 0.f;
        }
        *(LAS u32x2*)(P + (16 * tt + fr) * TS + 16 * st + 4 * fq) = pack4(acc);
    }
    __syncthreads();
    f32x4 oacc[4];
    bf16x8 vfr[2];
#pragma unroll
    for (int kk = 0; kk < 2; ++kk) vfr[kk] = ldfrag(VT + (16 * w + fr) * TS + 8 * fq + 32 * kk);
#pragma unroll
    for (int tt = 0; tt < 4; ++tt) {
        f32x4 acc = zero4();
#pragma unroll
        for (int kk = 0; kk < 2; ++kk) { const bf16x8 bp = ldfrag(P + (16 * tt + fr) * TS + 8 * fq + 32 * kk); acc = MFMA16(vfr[kk], bp, acc); }
#pragma unroll
        for (int kk = 0; kk < 4; ++kk) { const bf16x8 bq = ldfrag(QH + (16 * tt + fr) * QS + 8 * fq + 32 * kk); acc = MFMA16(sfr[kk], bq, acc); }
        oacc[tt] = acc;
        float s = (acc[0] * acc[0] + acc[1] * acc[1]) + (acc[2] * acc[2] + acc[3] * acc[3]);
        s += __shfl_xor(s, 16); s += __shfl_xor(s, 32);
        if (fq == 0) SSQ[(16 * tt + fr) * 8 + w] = s;
    }
    __syncthreads();
    const f32x4 gn = *(const f32x4*)(p.in[10] + e * 128 + 16 * w + 4 * fq);
#pragma unroll
    for (int tt = 0; tt < 4; ++tt) {
        const int t = 16 * tt + fr;
        const f32x4 q0 = *(const LAS f32x4*)(SSQ + t * 8), q1 = *(const LAS f32x4*)(SSQ + t * 8 + 4);
        const float tot = ((q0[0] + q0[1]) + (q0[2] + q0[3])) + ((q1[0] + q1[1]) + (q1[2] + q1[3]));
        const float rs = __builtin_amdgcn_rsqf(tot * (1.0f / 128.0f) + EPS);
        const f32x4 sg = unpack4(gsg[tt]);
        const f32x4 o = oacc[tt] * rs * gn * sg;
        *(u32x2*)(A2 + (size_t)(row0 + t) * 1024 + h * 128 + 16 * w + 4 * fq) = pack4(o);
    }
    __syncthreads();
}

__device__ __forceinline__ void hgrn_sample(const Params& p, LAS unsigned char* lds, int item, int e) {
    const int tid = fresh_tid(), b = item >> 2, h = item & 3, row0 = MP + b * 16;
    const bf16_t* PROJ = (const bf16_t*)(p.ws + WS_R + R_PROJ); const float* LF = (const float*)(p.ws + WS_R + R_LF);
    bf16_t* A2 = (bf16_t*)(p.ws + WS_R + R_A2);
    const float* S0 = p.in[2] + ((size_t)(e * 16 + b) * 4 + h) * 16384;
    float* Sn = p.out + O_HS + ((size_t)(e * 16 + b) * 4 + h) * 16384;
    LAS float* Bs = (LAS float*)lds;
    LAS float* Qs = Bs + 16 * 129;
    LAS float* Ks = Qs + 16 * 129;
    LAS float* Qh = Ks + 16 * 129;
    LAS float* Kh = Qh + 16 * 129;
    LAS float* Vs = Kh + 16 * 129;
    LAS float* Sc = Vs + 16 * 128;
    LAS float* Sq = Sc + 256;
    if (tid < 128) {
        float c = 0.f;
        for (int t = 0; t < 16; ++t) { const float lf = LF[(size_t)(row0 + t) * 512 + h * 128 + tid]; c += lf; Bs[t * 129 + tid] = c; Ks[t * 129 + tid] = 1.0f - __expf(lf); }
    }
    for (int idx = tid; idx < 2048; idx += NTHR) { const int t = idx >> 7, k = idx & 127;
        Qs[t * 129 + k] = bf2f(PROJ[(size_t)(row0 + t) * 2560 + h * 128 + k]);
        Vs[t * 128 + k] = bf2f(PROJ[(size_t)(row0 + t) * 2560 + 1024 + h * 128 + k]); }
    __syncthreads();
    for (int idx = tid; idx < 2048; idx += NTHR) { const int t = idx >> 7, k = idx & 127;
        const float bv = Bs[t * 129 + k];
        Qh[t * 129 + k] = Qs[t * 129 + k] * __expf(bv);
        Kh[t * 129 + k] = Ks[t * 129 + k] * __expf(Bs[15 * 129 + k] - bv); }
    { const int pr = tid >> 1, t = pr >> 4, s = pr & 15, hf = tid & 1;
      float a = 0.f;
      if (s <= t)
#pragma unroll 8
      for (int i = 0; i < 64; ++i) { const int k = hf * 64 + i; a += Qs[t * 129 + k] * Ks[s * 129 + k] * __expf(Bs[t * 129 + k] - Bs[s * 129 + k]); }
      a += __shfl_xor(a, 1);
      if (hf == 0) Sc[t * 16 + s] = a; }
    __syncthreads();
    { const int v = tid & 127, tq = tid >> 7;
      float o0 = 0.f, o1 = 0.f, o2 = 0.f, o3 = 0.f;
#pragma unroll 16
      for (int k = 0; k < 128; ++k) { const float sv = S0[(size_t)k * 128 + v];
          o0 += Qh[(4 * tq + 0) * 129 + k] * sv; o1 += Qh[(4 * tq + 1) * 129 + k] * sv; o2 += Qh[(4 * tq + 2) * 129 + k] * sv; o3 += Qh[(4 * tq + 3) * 129 + k] * sv; }
      for (int s = 0; s < 16; ++s) { const float vv = Vs[s * 128 + v];
          o0 += Sc[(4 * tq + 0) * 16 + s] * vv; o1 += Sc[(4 * tq + 1) * 16 + s] * vv; o2 += Sc[(4 * tq + 2) * 16 + s] * vv; o3 += Sc[(4 * tq + 3) * 16 + s] * vv; }
      float q0 = o0 * o0, q1 = o1 * o1, q2 = o2 * o2, q3 = o3 * o3;
      for (int o = 32; o >= 1; o >>= 1) { q0 += __shfl_xor(q0, o); q1 += __shfl_xor(q1, o); q2 += __shfl_xor(q2, o); q3 += __shfl_xor(q3, o); }
      const int hw = (tid >> 6) & 1;
      if ((tid & 63) == 0) { Sq[(4 * tq + 0) * 2 + hw] = q0; Sq[(4 * tq + 1) * 2 + hw] = q1; Sq[(4 * tq + 2) * 2 + hw] = q2; Sq[(4 * tq + 3) * 2 + hw] = q3; }
      __syncthreads();
      const float gn = p.in[10][e * 128 + v];
      float ov[4] = {o0, o1, o2, o3};
#pragma unroll
      for (int i = 0; i < 4; ++i) { const int t = 4 * tq + i;
          const float rs = __builtin_amdgcn_rsqf((Sq[t * 2] + Sq[t * 2 + 1]) * (1.0f / 128.0f) + EPS);
          const float sg = bf2f(PROJ[(size_t)(row0 + t) * 2560 + 1536 + h * 128 + v]);
          A2[(size_t)(row0 + t) * 1024 + h * 128 + v] = f2bf(ov[i] * rs * gn * sg); }
      float vr[16];
#pragma unroll
      for (int s = 0; s < 16; ++s) vr[s] = Vs[s * 128 + v];
#pragma unroll 8
      for (int kk = 0; kk < 32; ++kk) { const int k = tq * 32 + kk;
          float a = __expf(Bs[15 * 129 + k]) * S0[(size_t)k * 128 + v];
#pragma unroll
          for (int s = 0; s < 16; ++s) a += Kh[s * 129 + k] * vr[s];
          Sn[(size_t)k * 128 + v] = a; }
    }
    __syncthreads();
}

__device__ __forceinline__ void pool_phase(const Params& p, int e) {
    const bf16_t* PROJ = (const bf16_t*)(p.ws + WS_R + R_PROJ); bf16_t* A2 = (bf16_t*)(p.ws + WS_R + R_A2);
    const int nitems = (MA / 16) * 64;
    for (int it = blockIdx.x * NTHR + fresh_tid(); it < nitems; it += gridDim.x * NTHR) {
        const int cgp = it & 63, rr = it >> 6, ch0 = cgp * 8, g = ch0 >> 7, wlen = 2 << g, row0 = rr * 16;
        const bool smp = row0 >= MP;
        const int t0 = smp ? 0 : (row0 & 4095);
        const float* hist = smp ? p.in[3] + ((size_t)(e * 16 + ((row0 - MP) >> 4)) * 15) * 512 + ch0 : nullptr;
        const bf16_t* pb = PROJ + (size_t)row0 * 2560 + 2048 + ch0;
        float sum[8];
#pragma unroll
        for (int j = 0; j < 8; ++j) sum[j] = 0.f;
        for (int d = 1; d < wlen; ++d) {
            const int t = t0 - d;
            if (t >= 0) { const u32x4 q = *(const u32x4*)(pb - (size_t)d * 2560);
                sum[0] += bflo(q[0]); sum[1] += bfhi(q[0]); sum[2] += bflo(q[1]); sum[3] += bfhi(q[1]); sum[4] += bflo(q[2]); sum[5] += bfhi(q[2]); sum[6] += bflo(q[3]); sum[7] += bfhi(q[3]); }
            else if (smp) { const float* hp = hist + (size_t)(15 + t) * 512; const f32x4 a = *(const f32x4*)hp, bq = *(const f32x4*)(hp + 4);
                sum[0] += a[0]; sum[1] += a[1]; sum[2] += a[2]; sum[3] += a[3]; sum[4] += bq[0]; sum[5] += bq[1]; sum[6] += bq[2]; sum[7] += bq[3]; }
        }
#pragma unroll 4
        for (int i = 0; i < 16; ++i) {
            const u32x4 q = *(const u32x4*)(pb + (size_t)i * 2560);
            const float cur[8] = {bflo(q[0]), bfhi(q[0]), bflo(q[1]), bfhi(q[1]), bflo(q[2]), bfhi(q[2]), bflo(q[3]), bfhi(q[3])};
#pragma unroll
            for (int j = 0; j < 8; ++j) sum[j] += cur[j];
            const int t = t0 + i;
            const float cnt = smp ? (float)wlen : (float)((t + 1) < wlen ? (t + 1) : wlen);
            const float inv = 1.0f / cnt;
            float o[8];
#pragma unroll
            for (int j = 0; j < 8; ++j) o[j] = sum[j] * inv - cur[j];
            *(u32x4*)(A2 + (size_t)(row0 + i) * 1024 + 512 + ch0) = (u32x4){cvt_pk_bf16(o[0], o[1]), cvt_pk_bf16(o[2], o[3]), cvt_pk_bf16(o[4], o[5]), cvt_pk_bf16(o[6], o[7])};
            const int td = t - (wlen - 1);
            if (td >= 0) { const u32x4 r = *(const u32x4*)(pb + (ptrdiff_t)(i - (wlen - 1)) * 2560);
                sum[0] -= bflo(r[0]); sum[1] -= bfhi(r[0]); sum[2] -= bflo(r[1]); sum[3] -= bfhi(r[1]); sum[4] -= bflo(r[2]); sum[5] -= bfhi(r[2]); sum[6] -= bflo(r[3]); sum[7] -= bfhi(r[3]); }
            else if (smp) { const float* hp = hist + (size_t)(15 + td) * 512; const f32x4 a = *(const f32x4*)hp, bq = *(const f32x4*)(hp + 4);
                sum[0] -= a[0]; sum[1] -= a[1]; sum[2] -= a[2]; sum[3] -= a[3]; sum[4] -= bq[0]; sum[5] -= bq[1]; sum[6] -= bq[2]; sum[7] -= bq[3]; }
        }
    }
    const int nst = 24 * 15 * 512;
    for (int i = blockIdx.x * NTHR + fresh_tid(); i < nst; i += gridDim.x * NTHR) {
        const int ch = i & 511, r = (i >> 9) % 15, bb = (i >> 9) / 15;
        if (bb < 8) p.out[O_PP + ((size_t)(e * 8 + bb) * 15 + r) * 512 + ch] = bf2f(PROJ[(size_t)(bb * 4096 + 4081 + r) * 2560 + 2048 + ch]);
        else { const int b2 = bb - 8; p.out[O_PS + ((size_t)(e * 16 + b2) * 15 + r) * 512 + ch] = bf2f(PROJ[(size_t)(MP + b2 * 16 + 1 + r) * 2560 + 2048 + ch]); }
    }
}

constexpr int L_VNT = 0;
constexpr int L_WS = 69632;
constexpr int L_MU = 104448;
constexpr int L_RS = 104960;
__device__ __forceinline__ void gate_item(const Params& p, LAS unsigned char* lds, int item, int o) {
    const int tid = fresh_tid(), lane = tid & 63, w = tid >> 6, fr = lane & 15, fq = lane >> 4;
    const int n = item >> 3, g = item & 7, row0 = n * 128;
    bf16_t* UV = (bf16_t*)(p.ws + WS_R);
    const float* vst = (const float*)(p.ws + WS_VST);
    LAS bf16_t* VNT = (LAS bf16_t*)(lds + L_VNT); LAS bf16_t* WS = (LAS bf16_t*)(lds + L_WS);
    LAS float* MU = (LAS float*)(lds + L_MU); LAS float* RS = (LAS float*)(lds + L_RS);
    const int c0 = (tid & 31) * 8;
    f32x4 wv[8];
    { const float* wsrc = p.in[17] + (size_t)(o * 8 + g) * 16384;
#pragma unroll
      for (int i = 0; i < 8; ++i) { const int idx4 = tid + i * 512; wv[i] = *(const f32x4*)(wsrc + (idx4 >> 5) * 128 + (idx4 & 31) * 4); } }
    u32x4 qa[4], qb[4];
#pragma unroll
    for (int i = 0; i < 4; ++i) { const int s0 = ((tid >> 5) + i * 16) * 2;
        qa[i] = *(const u32x4*)(UV + (size_t)(row0 + s0) * 4096 + 2048 + g * 256 + c0);
        qb[i] = *(const u32x4*)(UV + (size_t)(row0 + s0 + 1) * 4096 + 2048 + g * 256 + c0); }
    u32x2 ur[8][2]; float bsv[8];
    { const float* bsp = p.in[18] + (size_t)(o * 8 + g) * 128;
#pragma unroll
      for (int tt = 0; tt < 8; ++tt) {
          const bf16_t* up = UV + (size_t)(row0 + 16 * tt + fr) * 4096 + g * 256 + 32 * w + 4 * fq;
          ur[tt][0] = *(const u32x2*)up; ur[tt][1] = *(const u32x2*)(up + 16); bsv[tt] = bsp[16 * tt + fr];
      } }
    const float* gp = p.in[15] + o * 2048 + g * 256 + c0; const float* bp = p.in[16] + o * 2048 + g * 256 + c0;
    const f32x4 g0 = *(const f32x4*)gp, g1 = *(const f32x4*)(gp + 4), h0 = *(const f32x4*)bp, h1 = *(const f32x4*)(bp + 4);
    if (tid < 128) { float sm = 0.f, sq = 0.f; const f32x4* vp = (const f32x4*)(vst + (size_t)(row0 + tid) * 64);
#pragma unroll
        for (int i = 0; i < 16; ++i) { const f32x4 t = vp[i]; sm += t[0] + t[2]; sq += t[1] + t[3]; }
        const float mean = sm * (1.0f / 2048.0f), var = fmaxf(sq * (1.0f / 2048.0f) - mean * mean, 0.f);
        MU[tid] = mean; RS[tid] = __builtin_amdgcn_rsqf(var + EPS); }
#pragma unroll
    for (int i = 0; i < 8; ++i) { const int idx4 = tid + i * 512, t = idx4 >> 5, s4 = (idx4 & 31) * 4;
        f32x4 v = wv[i];
        if (s4 >= 64 && t < 64) v = (f32x4){0.f, 0.f, 0.f, 0.f};
        *(LAS u32x2*)(WS + t * QS + s4) = pack4(v); }
    __syncthreads();
    { const float gg[8] = {g0[0], g0[1], g0[2], g0[3], g1[0], g1[1], g1[2], g1[3]}, hh[8] = {h0[0], h0[1], h0[2], h0[3], h1[0], h1[1], h1[2], h1[3]};
#pragma unroll
      for (int i = 0; i < 4; ++i) { const int s0 = ((tid >> 5) + i * 16) * 2;
          const float mua = MU[s0], rsa = RS[s0], mub = MU[s0 + 1], rsb = RS[s0 + 1];
          const float xa[8] = {bflo(qa[i][0]), bfhi(qa[i][0]), bflo(qa[i][1]), bfhi(qa[i][1]), bflo(qa[i][2]), bfhi(qa[i][2]), bflo(qa[i][3]), bfhi(qa[i][3])};
          const float xb[8] = {bflo(qb[i][0]), bfhi(qb[i][0]), bflo(qb[i][1]), bfhi(qb[i][1]), bflo(qb[i][2]), bfhi(qb[i][2]), bflo(qb[i][3]), bfhi(qb[i][3])};
#pragma unroll
          for (int j = 0; j < 8; ++j) *(LAS unsigned*)(VNT + (c0 + j) * QS + s0) = cvt_pk_bf16((xa[j] - mua) * rsa * gg[j] + hh[j], (xb[j] - mub) * rsb * gg[j] + hh[j]); } }
    __syncthreads();
    bf16x8 afr[2][4];
#pragma unroll
    for (int ct = 0; ct < 2; ++ct)
#pragma unroll
        for (int kk = 0; kk < 4; ++kk) afr[ct][kk] = ldfrag(VNT + (16 * (2 * w + ct) + fr) * QS + 8 * fq + 32 * kk);
#pragma unroll
    for (int tt = 0; tt < 8; ++tt) {
        f32x4 a0 = zero4(), a1 = zero4();
        const LAS bf16_t* wrow = WS + (16 * tt + fr) * QS + 8 * fq;
        { const bf16x8 bw0 = ldfrag(wrow), bw1 = ldfrag(wrow + 32);
          a0 = MFMA16(afr[0][0], bw0, a0); a1 = MFMA16(afr[1][0], bw0, a1);
          a0 = MFMA16(afr[0][1], bw1, a0); a1 = MFMA16(afr[1][1], bw1, a1); }
        if (tt >= 4) { const bf16x8 bw2 = ldfrag(wrow + 64), bw3 = ldfrag(wrow + 96);
          a0 = MFMA16(afr[0][2], bw2, a0); a1 = MFMA16(afr[1][2], bw2, a1);
          a0 = MFMA16(afr[0][3], bw3, a0); a1 = MFMA16(afr[1][3], bw3, a1); }
        bf16_t* up = UV + (size_t)(row0 + 16 * tt + fr) * 4096 + g * 256 + 32 * w + 4 * fq;
        *(u32x2*)up = pack4(unpack4(ur[tt][0]) * (a0 + bsv[tt]));
        *(u32x2*)(up + 16) = pack4(unpack4(ur[tt][1]) * (a1 + bsv[tt]));
    }
    __syncthreads();
}
__device__ __forceinline__ void gate_sample(const Params& p, LAS unsigned char* lds, int item, int o) {
    const int tid = fresh_tid(), b = item >> 3, g = item & 7, row0 = MP + b * 16;
    bf16_t* UV = (bf16_t*)(p.ws + WS_R);
    const float* vst = (const float*)(p.ws + WS_VST);
    LAS float* VN = (LAS float*)lds;
    LAS float* W16 = VN + 4096;
    LAS float* MU = W16 + 256; LAS float* RS = MU + 16;
    if (tid < 16) { float sm = 0.f, sq = 0.f; const f32x4* vp = (const f32x4*)(vst + (size_t)(row0 + tid) * 64);
        for (int i = 0; i < 16; ++i) { const f32x4 t = vp[i]; sm += t[0] + t[2]; sq += t[1] + t[3]; }
        const float mean = sm * (1.0f / 2048.0f), var = fmaxf(sq * (1.0f / 2048.0f) - mean * mean, 0.f);
        MU[tid] = mean; RS[tid] = __builtin_amdgcn_rsqf(var + EPS); }
    if (tid < 256) W16[tid] = p.in[17][(size_t)(o * 8 + g) * 16384 + (tid >> 4) * 128 + (tid & 15)];
    __syncthreads();
    for (int idx = tid; idx < 4096; idx += NTHR) { const int s = idx >> 8, c = idx & 255;
        const float x = bf2f(UV[(size_t)(row0 + s) * 4096 + 2048 + g * 256 + c]);
        const float vn = (x - MU[s]) * RS[s] * p.in[15][o * 2048 + g * 256 + c] + p.in[16][o * 2048 + g * 256 + c];
        VN[s * 256 + c] = vn;
        p.out[O_CV + ((size_t)(o * 16 + b) * 16 + s) * 2048 + g * 256 + c] = vn; }
    __syncthreads();
    { const int c = tid & 255, th = tid >> 8;
      for (int ti = 0; ti < 8; ++ti) { const int t = th * 8 + ti;
          float a = p.in[18][(size_t)(o * 8 + g) * 128 + t];
#pragma unroll
          for (int s = 0; s < 16; ++s) a += W16[t * 16 + s] * VN[s * 256 + c];
          bf16_t* up = UV + (size_t)(row0 + t) * 4096 + g * 256 + c;
          *up = f2bf(bf2f(*up) * a); } }
    __syncthreads();
}

__device__ __forceinline__ void ffn_eltwise(const Params& p, int l) {
    bf16_t* BIG = (bf16_t*)(p.ws + WS_R);
    const float* cw = p.in[21] + (size_t)l * 3 * 2816; const float* cb = p.in[22] + (size_t)l * 2816;
    const int nitems = (MA / 16) * 352;
    for (int it = blockIdx.x * NTHR + fresh_tid(); it < nitems; it += gridDim.x * NTHR) {
        const int cgp = it % 352, rr = it / 352, c0 = cgp * 8, row0 = rr * 16;
        const bool smp = row0 >= MP;
        const int t0 = smp ? 0 : (row0 & 4095);
        float w0[8], w1[8], w2[8], bs[8], am2[8], am1[8];
        { const f32x4 a = *(const f32x4*)(cw + c0), b = *(const f32x4*)(cw + c0 + 4); w0[0] = a[0]; w0[1] = a[1]; w0[2] = a[2]; w0[3] = a[3]; w0[4] = b[0]; w0[5] = b[1]; w0[6] = b[2]; w0[7] = b[3]; }
        { const f32x4 a = *(const f32x4*)(cw + 2816 + c0), b = *(const f32x4*)(cw + 2816 + c0 + 4); w1[0] = a[0]; w1[1] = a[1]; w1[2] = a[2]; w1[3] = a[3]; w1[4] = b[0]; w1[5] = b[1]; w1[6] = b[2]; w1[7] = b[3]; }
        { const f32x4 a = *(const f32x4*)(cw + 5632 + c0), b = *(const f32x4*)(cw + 5632 + c0 + 4); w2[0] = a[0]; w2[1] = a[1]; w2[2] = a[2]; w2[3] = a[3]; w2[4] = b[0]; w2[5] = b[1]; w2[6] = b[2]; w2[7] = b[3]; }
        { const f32x4 a = *(const f32x4*)(cb + c0), b = *(const f32x4*)(cb + c0 + 4); bs[0] = a[0]; bs[1] = a[1]; bs[2] = a[2]; bs[3] = a[3]; bs[4] = b[0]; bs[5] = b[1]; bs[6] = b[2]; bs[7] = b[3]; }
        if (t0 == 0) {
            if (smp) { const float* hp = p.in[4] + ((size_t)(l * 16 + ((row0 - MP) >> 4)) * 2) * 2816 + c0;
                const f32x4 a = *(const f32x4*)hp, b = *(const f32x4*)(hp + 4), c = *(const f32x4*)(hp + 2816), d = *(const f32x4*)(hp + 2816 + 4);
                am2[0] = a[0]; am2[1] = a[1]; am2[2] = a[2]; am2[3] = a[3]; am2[4] = b[0]; am2[5] = b[1]; am2[6] = b[2]; am2[7] = b[3];
                am1[0] = c[0]; am1[1] = c[1]; am1[2] = c[2]; am1[3] = c[3]; am1[4] = d[0]; am1[5] = d[1]; am1[6] = d[2]; am1[7] = d[3]; }
            else {
#pragma unroll
                for (int j = 0; j < 8; ++j) { am2[j] = 0.f; am1[j] = 0.f; } }
        } else {
            const u32x4 q2 = *(const u32x4*)(BIG + (size_t)(row0 - 2) * 5632 + c0), q1 = *(const u32x4*)(BIG + (size_t)(row0 - 1) * 5632 + c0);
            am2[0] = bflo(q2[0]); am2[1] = bfhi(q2[0]); am2[2] = bflo(q2[1]); am2[3] = bfhi(q2[1]); am2[4] = bflo(q2[2]); am2[5] = bfhi(q2[2]); am2[6] = bflo(q2[3]); am2[7] = bfhi(q2[3]);
            am1[0] = bflo(q1[0]); am1[1] = bfhi(q1[0]); am1[2] = bflo(q1[1]); am1[3] = bfhi(q1[1]); am1[4] = bflo(q1[2]); am1[5] = bfhi(q1[2]); am1[6] = bflo(q1[3]); am1[7] = bfhi(q1[3]);
        }
#pragma unroll 4
        for (int i = 0; i < 16; ++i) {
            bf16_t* rp = BIG + (size_t)(row0 + i) * 5632 + c0;
            const u32x4 qa = *(const u32x4*)rp, qg = *(const u32x4*)(rp + 2816);
            const float a[8] = {bflo(qa[0]), bfhi(qa[0]), bflo(qa[1]), bfhi(qa[1]), bflo(qa[2]), bfhi(qa[2]), bflo(qa[3]), bfhi(qa[3])};
            const float gt[8] = {bflo(qg[0]), bfhi(qg[0]), bflo(qg[1]), bfhi(qg[1]), bflo(qg[2]), bfhi(qg[2]), bflo(qg[3]), bfhi(qg[3])};
            float y[8];
#pragma unroll
            for (int j = 0; j < 8; j += 2) {
                const f32x2 cv = (f32x2){bs[j] + am2[j] * w0[j] + am1[j] * w1[j] + a[j] * w2[j], bs[j + 1] + am2[j + 1] * w0[j + 1] + am1[j + 1] * w1[j + 1] + a[j + 1] * w2[j + 1]};
                const f32x2 ge = gelu_pk(cv);
                y[j] = ge.x * gt[j]; y[j + 1] = ge.y * gt[j + 1];
            }
            *(u32x4*)(rp + 2816) = (u32x4){cvt_pk_bf16(y[0], y[1]), cvt_pk_bf16(y[2], y[3]), cvt_pk_bf16(y[4], y[5]), cvt_pk_bf16(y[6], y[7])};
#pragma unroll
            for (int j = 0; j < 8; ++j) { am2[j] = am1[j]; am1[j] = a[j]; }
        }
    }
    const int nst = 24 * 2 * 2816;
    for (int i = blockIdx.x * NTHR + fresh_tid(); i < nst; i += gridDim.x * NTHR) {
        const int c = i % 2816, j = (i / 2816) & 1, bb = i / 5632;
        if (bb < 8) p.out[O_CP + ((size_t)(l * 8 + bb) * 2 + j) * 2816 + c] = bf2f(BIG[(size_t)(bb * 4096 + 4094 + j) * 5632 + c]);
        else { const int b2 = bb - 8; p.out[O_CS + ((size_t)(l * 16 + b2) * 2 + j) * 2816 + c] = bf2f(BIG[(size_t)(MP + b2 * 16 + 14 + j) * 5632 + c]); }
    }
}


__device__ __forceinline__ void ffn_fixup(const Params& p, int l) {
    bf16_t* Y = (bf16_t*)(p.ws + WS_R + R_Y); const float* EDGE = (const float*)(p.ws + WS_R + R_EDGE); const bf16_t* SBUF = (const bf16_t*)(p.ws + WS_R + R_SBUF);
    const float* cw = p.in[21] + (size_t)l * 3 * 2816; const float* cb = p.in[22] + (size_t)l * 2816;
    const int gtid = blockIdx.x * NTHR + fresh_tid(), gth = gridDim.x * NTHR;
    for (int it = gtid; it < 128 * 4 * 352; it += gth) {
        const int c0 = (it % 352) * 8, r = (it / 352) & 3, pm = it / 1408;
        const float* e = EDGE + (size_t)pm * 12 * 2816 + c0; const float* ep = EDGE + (size_t)(pm - 1) * 12 * 2816 + c0;
        const bool first = (pm & 15) == 0;
        int kc, kg, k1, k2;
        if (r == 0) { kc = 0; kg = 2; k1 = first ? -1 : 12 + 11; k2 = first ? -1 : 12 + 10; }
        else if (r == 1) { kc = 1; kg = 3; k1 = 0; k2 = first ? -1 : 12 + 11; }
        else if (r == 2) { kc = 6; kg = 8; k1 = 5; k2 = 4; }
        else { kc = 7; kg = 9; k1 = 6; k2 = 5; }
        float y[8];
#pragma unroll
        for (int h = 0; h < 2; ++h) {
            const f32x4 cur = *(const f32x4*)(e + (size_t)kc * 2816 + 4 * h), gt = *(const f32x4*)(e + (size_t)kg * 2816 + 4 * h);
            const f32x4 z = (f32x4){0.f, 0.f, 0.f, 0.f};
            const f32x4 p1 = (k1 < 0) ? z : (k1 >= 12 ? *(const f32x4*)(ep + (size_t)(k1 - 12) * 2816 + 4 * h) : *(const f32x4*)(e + (size_t)k1 * 2816 + 4 * h));
            const f32x4 p2 = (k2 < 0) ? z : (k2 >= 12 ? *(const f32x4*)(ep + (size_t)(k2 - 12) * 2816 + 4 * h) : *(const f32x4*)(e + (size_t)k2 * 2816 + 4 * h));
            const f32x4 w0 = *(const f32x4*)(cw + c0 + 4 * h), w1 = *(const f32x4*)(cw + 2816 + c0 + 4 * h), w2 = *(const f32x4*)(cw + 5632 + c0 + 4 * h), bb = *(const f32x4*)(cb + c0 + 4 * h);
            const f32x4 ge = gelu4(bb + w0 * p2 + w1 * p1 + w2 * cur);
#pragma unroll
            for (int j = 0; j < 4; ++j) y[4 * h + j] = ge[j] * gt[j];
        }
        const int orow = pm * 256 + (r < 2 ? r : 126 + r);
        *(u32x4*)(Y + (size_t)orow * 2816 + c0) = (u32x4){cvt_pk_bf16(y[0], y[1]), cvt_pk_bf16(y[2], y[3]), cvt_pk_bf16(y[4], y[5]), cvt_pk_bf16(y[6], y[7])};
    }
    for (int it = gtid; it < 16 * 352; it += gth) {
        const int c0 = (it % 352) * 8, b = it / 352;
        float w0[8], w1[8], w2[8], bs[8], am2[8], am1[8];
        { const f32x4 a = *(const f32x4*)(cw + c0), bq = *(const f32x4*)(cw + c0 + 4), c = *(const f32x4*)(cw + 2816 + c0), d = *(const f32x4*)(cw + 2816 + c0 + 4);
          const f32x4 e = *(const f32x4*)(cw + 5632 + c0), f = *(const f32x4*)(cw + 5632 + c0 + 4), g = *(const f32x4*)(cb + c0), h = *(const f32x4*)(cb + c0 + 4);
#pragma unroll
          for (int j = 0; j < 4; ++j) { w0[j] = a[j]; w0[4 + j] = bq[j]; w1[j] = c[j]; w1[4 + j] = d[j]; w2[j] = e[j]; w2[4 + j] = f[j]; bs[j] = g[j]; bs[4 + j] = h[j]; } }
        { const float* hp = p.in[4] + ((size_t)(l * 16 + b) * 2) * 2816 + c0;
          const f32x4 a = *(const f32x4*)hp, bq = *(const f32x4*)(hp + 4), c = *(const f32x4*)(hp + 2816), d = *(const f32x4*)(hp + 2816 + 4);
#pragma unroll
          for (int j = 0; j < 4; ++j) { am2[j] = a[j]; am2[4 + j] = bq[j]; am1[j] = c[j]; am1[4 + j] = d[j]; } }
#pragma unroll 4
        for (int i = 0; i < 16; ++i) {
            const bf16_t* rp = SBUF + (size_t)(b * 16 + i) * 5632 + c0;
            const u32x4 qa = *(const u32x4*)rp, qg = *(const u32x4*)(rp + 2816);
            const float a[8] = {bflo(qa[0]), bfhi(qa[0]), bflo(qa[1]), bfhi(qa[1]), bflo(qa[2]), bfhi(qa[2]), bflo(qa[3]), bfhi(qa[3])};
            const float gt[8] = {bflo(qg[0]), bfhi(qg[0]), bflo(qg[1]), bfhi(qg[1]), bflo(qg[2]), bfhi(qg[2]), bflo(qg[3]), bfhi(qg[3])};
            float y[8];
#pragma unroll
            for (int j = 0; j < 8; j += 2) {
                const f32x2 cv = (f32x2){bs[j] + am2[j] * w0[j] + am1[j] * w1[j] + a[j] * w2[j], bs[j + 1] + am2[j + 1] * w0[j + 1] + am1[j + 1] * w1[j + 1] + a[j + 1] * w2[j + 1]};
                const f32x2 ge = gelu_pk(cv);
                y[j] = ge.x * gt[j]; y[j + 1] = ge.y * gt[j + 1];
            }
            *(u32x4*)(Y + (size_t)(MP + b * 16 + i) * 2816 + c0) = (u32x4){cvt_pk_bf16(y[0], y[1]), cvt_pk_bf16(y[2], y[3]), cvt_pk_bf16(y[4], y[5]), cvt_pk_bf16(y[6], y[7])};
#pragma unroll
            for (int j = 0; j < 8; ++j) { am2[j] = am1[j]; am1[j] = a[j]; }
        }
    }
    for (int i = gtid; i < 24 * 2 * 2816; i += gth) {
        const int c = i % 2816, j = (i / 2816) & 1, bb = i / 5632;
        if (bb < 8) p.out[O_CP + ((size_t)(l * 8 + bb) * 2 + j) * 2816 + c] = EDGE[((size_t)(bb * 16 + 15) * 12 + 10 + j) * 2816 + c];
        else { const int b2 = bb - 8; p.out[O_CS + ((size_t)(l * 16 + b2) * 2 + j) * 2816 + c] = bf2f(SBUF[(size_t)(b2 * 16 + 14 + j) * 5632 + c]); }
    }
}

__device__ __forceinline__ void final_norm(const Params& p) {
    const float* ss = (const float*)(p.ws + WS_SS) + (size_t)8 * MA * 16;
    const bf16_t* Xb = (const bf16_t*)(p.ws + WS_XB);
    const int tid = fresh_tid(), wave = tid >> 6, lane = tid & 63;
    f32x4 gn[4];
#pragma unroll
    for (int j = 0; j < 4; ++j) gn[j] = *(const f32x4*)(p.in[7] + (j >> 1) * 512 + lane * 8 + (j & 1) * 4);
#pragma unroll 2
    for (int row = blockIdx.x * 8 + wave; row < MA; row += gridDim.x * 8) {
        const float rs = row_rstd(ss, row);
        float* yp = p.out + (size_t)row * 1024;
#pragma unroll
        for (int hh = 0; hh < 2; ++hh) {
            const u32x4 q = *(const u32x4*)(Xb + (size_t)row * 1024 + hh * 512 + lane * 8);
            const f32x4 v0 = (f32x4){bflo(q[0]), bfhi(q[0]), bflo(q[1]), bfhi(q[1])} * rs * gn[hh * 2];
            const f32x4 v1 = (f32x4){bflo(q[2]), bfhi(q[2]), bflo(q[3]), bfhi(q[3])} * rs * gn[hh * 2 + 1];
            *(f32x4*)(yp + hh * 512 + lane * 8) = v0; *(f32x4*)(yp + hh * 512 + lane * 8 + 4) = v1;
        }
    }
}

__device__ __forceinline__ void dbg_rowsum_bf16(const bf16_t* src, int rows, size_t ld, int ncols, float* dst) {
    const int wave = threadIdx.x >> 6, lane = threadIdx.x & 63;
    for (int r = blockIdx.x * 8 + wave; r < rows; r += gridDim.x * 8) {
        float s = 0.f;
        for (int c = lane; c < ncols; c += 64) s += bf2f(src[(size_t)r * ld + c]);
        for (int o = 32; o >= 1; o >>= 1) s += __shfl_xor(s, o);
        if (lane == 0) dst[r] = s;
    }
}
__device__ __forceinline__ void dbg_dump(const Params& p, int kind) {
    if (kind == 1) { const float* ss = (const float*)(p.ws + WS_SS); for (int i = blockIdx.x * NTHR + threadIdx.x; i < 9 * MA * 16; i += gridDim.x * NTHR) p.out[i] = ss[i]; }
    else if (kind == 2) { dbg_rowsum_bf16((const bf16_t*)(p.ws + WS_R), MA, 5632, 2816, p.out); dbg_rowsum_bf16((const bf16_t*)(p.ws + WS_R) + 2816, MA, 5632, 2816, p.out + MA); }
    else if (kind == 3) { dbg_rowsum_bf16((const bf16_t*)(p.ws + WS_W0), 14592, 1024, 1024, p.out); dbg_rowsum_bf16((const bf16_t*)(p.ws + WS_W0 + SLOT_BYTES), 14592, 1024, 1024, p.out + 14592); }
    else if (kind == 4) { dbg_rowsum_bf16((const bf16_t*)(p.ws + WS_XB), MA, 1024, 1024, p.out); }
}

#define XB_TMO      128
#define XB_XCNT(j)  (256  + 64 * (j))
#define XB_XSUB(j)  (1280 + 64 * (j))
#define XB_XGEN(j)  (2304 + 64 * (j))
#define XB_TOP      3328
#define XB_TOPGEN   3392
#define XCD_BAR_WORDS 3456
#define XB_SPIN_CAP (1u << 18)
__device__ __forceinline__ unsigned xb_ld(unsigned* p)              { return __hip_atomic_load(p, __ATOMIC_RELAXED, __HIP_MEMORY_SCOPE_AGENT); }
__device__ __forceinline__ unsigned xb_add(unsigned* p, unsigned v) { return __hip_atomic_fetch_add(p, v, __ATOMIC_RELAXED, __HIP_MEMORY_SCOPE_AGENT); }
__device__ __forceinline__ unsigned xb_xcc_id() { return (unsigned)__builtin_amdgcn_s_getreg((3 << 11) | 20) & 0xFu; }
#define XB_SPIN(cond, bar) do { unsigned _sp = 0; while (cond) { __builtin_amdgcn_s_sleep(1); \
    if ((++_sp & 255u) == 0u) { if (xb_ld(&(bar)[XB_TMO])) break; if (_sp > XB_SPIN_CAP) { atomicAdd(&(bar)[XB_TMO], 1u); break; } } } } while (0)
struct XcdBarrier { unsigned* bar; unsigned x; volatile LAS unsigned* st; };
__device__ __forceinline__ XcdBarrier xcd_barrier_post(unsigned* bar, volatile LAS unsigned* st) {
    XcdBarrier b; b.bar = bar; b.x = xb_xcc_id(); b.st = st;
    if (threadIdx.x == 0) (void)xb_add(&bar[XB_XCNT(b.x)], 1u);
    return b;
}
__device__ __forceinline__ void xcd_barrier_complete(unsigned* bar, unsigned x, unsigned& nloc, unsigned& nx) {
    const unsigned G = gridDim.x * gridDim.y * gridDim.z;
    unsigned sum, cnt, mine, sp = 0u;
    for (;;) {
        sum = 0u; cnt = 0u; mine = 0u;
#pragma unroll
        for (unsigned j = 0; j < 16; ++j) { const unsigned c = xb_ld(&bar[XB_XCNT(j)]); sum += c; cnt += (c > 0u) ? 1u : 0u; mine = (j == x) ? c : mine; }
        if (sum == G) break;
        __builtin_amdgcn_s_sleep(1);
        if ((++sp & 255u) == 0u) { if (xb_ld(&bar[XB_TMO])) break; if (sp > XB_SPIN_CAP) { atomicAdd(&bar[XB_TMO], 1u); break; } }
    }
    nloc = mine > 0u ? mine : 1u; nx = cnt > 0u ? cnt : 1u;
}
__device__ __forceinline__ void xcd_barrier(const XcdBarrier& b) {
    asm volatile("s_waitcnt vmcnt(0)" ::: "memory");
    __syncthreads();
    if (threadIdx.x == 0) {
        unsigned* bar = b.bar;
        __builtin_amdgcn_s_waitcnt(0);
        unsigned nloc = b.st[0], nx = b.st[1];
        if (nloc == 0u) { xcd_barrier_complete(bar, b.x, nloc, nx); b.st[0] = nloc; b.st[1] = nx; }
        const unsigned old = xb_add(&bar[XB_XSUB(b.x)], 1u);
        const unsigned gen = old / nloc;
        if (old + 1u == (gen + 1u) * nloc) {
            __builtin_amdgcn_fence(__ATOMIC_RELEASE, "agent");
            asm volatile("s_waitcnt vmcnt(0)" ::: "memory");
            const unsigned og = xb_add(&bar[XB_TOP], 1u);
            const unsigned tg = og / nx;
            if (og + 1u == (tg + 1u) * nx) xb_add(&bar[XB_TOPGEN], 1u);
            else XB_SPIN(xb_ld(&bar[XB_TOPGEN]) == tg, bar);
            __builtin_amdgcn_fence(__ATOMIC_ACQUIRE, "agent");
            xb_add(&bar[XB_XGEN(b.x)], 1u);
            asm volatile("s_waitcnt vmcnt(0)" ::: "memory");
        } else {
            XB_SPIN(xb_ld(&bar[XB_XGEN(b.x)]) == gen, bar);
            __builtin_amdgcn_fence(__ATOMIC_ACQUIRE, "agent");
            asm volatile("s_waitcnt vmcnt(0)" ::: "memory");
        }
    }
    __syncthreads();
}

__global__ void __launch_bounds__(NTHR, 2) mega(Params p) {
    extern __shared__ __attribute__((aligned(16))) unsigned char shm[];
    LAS unsigned char* lds = (LAS unsigned char*)shm;
    cg::grid_group grid = cg::this_grid();
    const int bid = blockIdx.x, nb = gridDim.x;
    int ph = 0;
#define ACTIVE() (p.ph_lo <= ph && ph < p.ph_hi)
#define STRONG_SYNC() do { asm volatile("s_waitcnt vmcnt(0) lgkmcnt(0)" ::: "memory"); grid.sync(); \
        if (threadIdx.x < 64) { __builtin_amdgcn_fence(__ATOMIC_ACQUIRE, "agent"); asm volatile("s_waitcnt vmcnt(0)" ::: "memory"); } __syncthreads(); } while (0)
#define SEAM() do { if (p.ph_lo <= ph && ph + 1 < p.ph_hi) { if (p.ph_hi < 0) STRONG_SYNC(); xcd_barrier(xbar); } ++ph; } while (0)
    float* ss = (float*)(p.ws + WS_SS);
    bf16_t* Xb = (bf16_t*)(p.ws + WS_XB);
    if (threadIdx.x < 4) ((volatile LAS unsigned*)(lds + 135168))[threadIdx.x] = 0u;
    __syncthreads();
    const XcdBarrier xbar = xcd_barrier_post((unsigned*)(p.ws + WS_BAR), (volatile LAS unsigned*)(lds + 135168));
    if (ACTIVE() && (PHM & 1)) phase0(p, lds);
    SEAM();
    for (int l = 0; l < 4; ++l) {
        const bf16_t* slot = (const bf16_t*)(p.ws + WS_W0 + (size_t)(l & 1) * SLOT_BYTES);
        const int h = l >> 1;
        size_t ffo_in, ffo_out;
        if ((l & 1) == 0) {
            ffo_in = 3670016; ffo_out = 9437184;
            if (ACTIVE() && (PHM & 2)) {
                pg8::Gemm g{Xb, slot, MP, 2560, 1024, 1024}; pg8::StaticOrder S; S.init(MP, 2560, nb, bid);
                EpiAB E{(bf16_t*)(p.ws + WS_R + R_PROJ), (float*)(p.ws + WS_R + R_LF), ss + (size_t)(2 * l) * MA * 16, (const float*)(p.ws + WS_LB) + h * 512};
                pg8::gemm_phase(lds, g, S, E);
                SEpiAB SE{E.PROJ, E.LF, E.ssin, E.lb};
                sample_gemm(lds, Xb + (size_t)MP * 1024, 1024, slot, 1024, 2560, SE);
            }
            SEAM();
            if (ACTIVE() && (PHM & 4)) {
                for (int item = bid; item < 2048; item += nb) hgrn_pass1(p, lds, item);
                for (int item = nb - 1 - bid; item < 64; item += nb) hgrn_sample(p, lds, item, h);
                pool_phase(p, h);
                if (l == 2) prep_layer(p, lds, 3);
            }
            SEAM();
            if (ACTIVE() && (PHM & 8)) hgrn_pass2(p, h);
            SEAM();
            if (ACTIVE() && (PHM & 16)) { for (int item = bid; item < 2048; item += nb) hgrn_pass3(p, lds, item, h); }
            SEAM();
            if (ACTIVE() && (PHM & 32)) {
                pg8::Gemm g{(const bf16_t*)(p.ws + WS_R + R_A2), slot + 2621440, MP, 1024, 1024, 1024}; pg8::StaticOrder S; S.init(MP, 1024, nb, bid);
                EpiRes E{Xb, ss + (size_t)(2 * l + 1) * MA * 16};
                pg8::gemm_phase(lds, g, S, E);
                SEpiRes SE{Xb, E.ssout};
                sample_gemm(lds, (const bf16_t*)(p.ws + WS_R + R_A2) + (size_t)MP * 1024, 1024, slot + 2621440, 1024, 1024, SE);
            }
            SEAM();
        } else {
            ffo_in = 6291456; ffo_out = 12058624;
            if (ACTIVE() && (PHM & 64)) {
                pg8::Gemm g{Xb, slot, MP, 4096, 1024, 1024}; pg8::StaticOrder S; S.init(MP, 4096, nb, bid);
                EpiUV E{(bf16_t*)(p.ws + WS_R), ss + (size_t)(2 * l) * MA * 16, (float*)(p.ws + WS_VST)};
                pg8::gemm_phase(lds, g, S, E);
                SEpiUV SE{E.UV, E.ssin, E.vst};
                sample_gemm(lds, Xb + (size_t)MP * 1024, 1024, slot, 1024, 4096, SE);
            }
            SEAM();
            if (ACTIVE() && (PHM & 128)) {
                for (int item = bid; item < 2048; item += nb) gate_item(p, lds, item, h);
                for (int item = nb - 1 - bid; item < 128; item += nb) gate_sample(p, lds, item, h);
                if (l == 1) prep_layer(p, lds, 2);
            }
            SEAM();
            if (ACTIVE() && (PHM & 256)) {
                pg8::Gemm g{(const bf16_t*)(p.ws + WS_R), slot + 4194304, MP, 1024, 2048, 4096}; pg8::StaticOrder S; S.init(MP, 1024, nb, bid);
                EpiRes E{Xb, ss + (size_t)(2 * l + 1) * MA * 16};
                pg8::gemm_phase(lds, g, S, E);
                SEpiRes SE{Xb, E.ssout};
                sample_gemm(lds, (const bf16_t*)(p.ws + WS_R) + (size_t)MP * 4096, 4096, slot + 4194304, 2048, 1024, SE);
            }
            SEAM();
        }
        if (ACTIVE() && (PHM & 512)) {
            pg8::Gemm g{Xb, slot + ffo_in, MP, 5632, 1024, 1024}; pg8::StaticOrder S; S.init(MP, 5632, nb, bid);
            EpiFF2 E{(bf16_t*)(p.ws + WS_R + R_Y), (float*)(p.ws + WS_R + R_EDGE), ss + (size_t)(2 * l + 1) * MA * 16, p.in[21] + (size_t)l * 3 * 2816, p.in[22] + (size_t)l * 2816};
            pg8::gemm_phase(lds, g, S, E);
            SEpiFF2 SE{(bf16_t*)(p.ws + WS_R + R_SBUF), E.ssin};
            sample_gemm(lds, Xb + (size_t)MP * 1024, 1024, slot + ffo_in, 1024, 5632, SE);
        }
        SEAM();
        if (ACTIVE() && (PHM & 1024)) ffn_fixup(p, l);
        SEAM();
        if (ACTIVE() && (PHM & 2048)) {
            pg8::Gemm g{(const bf16_t*)(p.ws + WS_R + R_Y), slot + ffo_out, MP, 1024, 2816, 2816}; pg8::StaticOrder S; S.init(MP, 1024, nb, bid);
            EpiRes E{Xb, ss + (size_t)(2 * l + 2) * MA * 16};
            pg8::gemm_phase(lds, g, S, E);
            SEpiRes SE{Xb, E.ssout};
            sample_gemm(lds, (const bf16_t*)(p.ws + WS_R + R_Y) + (size_t)MP * 2816, 2816, slot + ffo_out, 2816, 1024, SE);
        }
        SEAM();
    }
    if (ACTIVE() && (PHM & 4096)) final_norm(p);
#undef ACTIVE
#undef SEAM
}
constexpr int N_PHASES = 1 + 2 * 8 + 2 * 6 + 1;

extern "C" void kernel_launch(void* const* d_in, const int* in_sizes, int n_in, void* d_out, int out_size, void* d_ws, size_t ws_size, hipStream_t stream) {
    static int grid = 0;
    if (grid == 0) {
        if (n_in != 24 || (size_t)out_size != O_END || ws_size < WS_END) { fprintf(stderr, "kernel_launch: unexpected shapes (n_in %d, out %d, ws %zu, need %zu)\n", n_in, out_size, ws_size, (size_t)WS_END); grid = -1; return; }
        int dev = 0, cus = 0, per_cu = 0;
        hipGetDevice(&dev); hipDeviceGetAttribute(&cus, hipDeviceAttributeMultiprocessorCount, dev);
        if (hipFuncSetAttribute((const void*)mega, hipFuncAttributeMaxDynamicSharedMemorySize, LDS_BYTES) != hipSuccess) { fprintf(stderr, "kernel_launch: hipFuncSetAttribute failed\n"); grid = -1; return; }
        if (hipOccupancyMaxActiveBlocksPerMultiprocessor(&per_cu, (const void*)mega, NTHR, LDS_BYTES) != hipSuccess || per_cu < 1) { fprintf(stderr, "kernel_launch: occupancy query says %d\n", per_cu); per_cu = 1; }
        (void)hipGetLastError();
        grid = cus;
    }
    if (grid < 0) return;
    if (hipMemsetAsync((char*)d_ws + WS_BAR, 0, XCD_BAR_WORDS * 4, stream) != hipSuccess) { fprintf(stderr, "kernel_launch: memset of the barrier words failed\n"); return; }
    Params p{};
    for (int i = 0; i < 24; ++i) p.in[i] = (const float*)d_in[i];
    p.out = (float*)d_out; p.ws = (unsigned char*)d_ws;
#if MULTI_LAUNCH
    for (int ph = 0; ph < N_PHASES; ++ph) { p.ph_lo = ph; p.ph_hi = ph + 1; hipLaunchKernelGGL(mega, dim3(grid), dim3(NTHR), LDS_BYTES, stream, p); }
#else
    p.ph_lo = 0; p.ph_hi = (PH_CUT < N_PHASES) ? PH_CUT : N_PHASES; p.dbg = DBG_PHASE; p.pad = DBG_KIND;
    void* args[] = {&p};
    hipError_t e = hipLaunchCooperativeKernel((const void*)mega, dim3(grid), dim3(NTHR), args, LDS_BYTES, stream);
    if (e != hipSuccess) fprintf(stderr, "cooperative launch failed: %s (grid %d)\n", hipGetErrorString(e), grid);
#endif
}
```

```cpp
#include <hip/hip_runtime.h>
#include <hip/hip_cooperative_groups.h>
#include <cstdio>
namespace cg = cooperative_groups;

#ifndef MULTI_LAUNCH
#define MULTI_LAUNCH 0
#endif

#ifndef PH_CUT
#define PH_CUT 100
#define DBG_PHASE 19
#define DBG_KIND 0
#endif
#ifndef DUP
#define DUP 0
#endif
#ifndef PHM
#define PHM 0xFFFF
#endif
#define LAS __attribute__((address_space(3)))
typedef unsigned short bf16_t;
typedef short bf16x8 __attribute__((ext_vector_type(8)));
typedef float f32x4 __attribute__((ext_vector_type(4)));
typedef float f32x2 __attribute__((ext_vector_type(2)));
typedef unsigned u32x4 __attribute__((ext_vector_type(4)));
typedef unsigned u32x2 __attribute__((ext_vector_type(2)));

constexpr int MP = 32768, MS = 256, MA = MP + MS;
constexpr float EPS = 1e-6f;
constexpr int NTHR = 512;
constexpr int LDS_BYTES = 131072 + 4096 + 16;

constexpr size_t al256(size_t x) { return (x + 255) & ~(size_t)255; }
constexpr size_t WS_SS = 0;
constexpr size_t WS_VST = al256(WS_SS + (size_t)9 * MA * 16 * 4);
constexpr size_t WS_LB = al256(WS_VST + (size_t)MA * 64 * 4);
constexpr size_t WS_W0 = al256(WS_LB + 4096);
constexpr size_t SLOT_ELEMS = 14942208;
constexpr size_t SLOT_BYTES = SLOT_ELEMS * 2;
constexpr size_t WS_XB = al256(WS_W0 + 2 * SLOT_BYTES);
constexpr size_t WS_R = al256(WS_XB + (size_t)MA * 1024 * 2);
constexpr size_t R_PROJ = 0;
constexpr size_t R_LF = al256((size_t)MA * 2560 * 2);
constexpr size_t R_A2 = al256(R_LF + (size_t)MA * 512 * 4);
constexpr size_t R_ST = al256(R_A2 + (size_t)MA * 1024 * 2);
constexpr size_t R_DEC = al256(R_ST + (size_t)2048 * 16384 * 2);
constexpr size_t R_EVEN_END = R_DEC + (size_t)2048 * 128 * 4;
constexpr size_t R_Y = 0;
constexpr size_t R_EDGE = al256((size_t)MA * 2816 * 2);
constexpr size_t R_SBUF = al256(R_EDGE + (size_t)128 * 12 * 2816 * 4);
constexpr size_t R_FFN_END = R_SBUF + (size_t)256 * 5632 * 2;
constexpr size_t R_SIZE = R_EVEN_END > R_FFN_END ? R_EVEN_END : R_FFN_END;
constexpr size_t WS_BAR = al256(WS_R + R_SIZE);
constexpr size_t WS_END = WS_BAR + 3456 * 4;

constexpr size_t O_Y = 0;
constexpr size_t O_HP = (size_t)MA * 1024;
constexpr size_t O_HS = O_HP + (size_t)2 * 8 * 4 * 16384;
constexpr size_t O_PP = O_HS + (size_t)2 * 16 * 4 * 16384;
constexpr size_t O_PS = O_PP + (size_t)2 * 8 * 15 * 512;
constexpr size_t O_CP = O_PS + (size_t)2 * 16 * 15 * 512;
constexpr size_t O_CS = O_CP + (size_t)4 * 8 * 2 * 2816;
constexpr size_t O_CV = O_CS + (size_t)4 * 16 * 2 * 2816;
constexpr size_t O_END = O_CV + (size_t)2 * 16 * 16 * 2048;

struct Params { const float* in[24]; float* out; unsigned char* ws; int ph_lo, ph_hi, dbg, pad; };

__device__ __forceinline__ int fresh_tid() { int t = threadIdx.x; asm volatile("" : "+v"(t)); return t; }
typedef __bf16 bf16x2_t __attribute__((ext_vector_type(2)));
__device__ __forceinline__ unsigned cvt_pk_bf16(float lo, float hi) { const f32x2 v = {lo, hi}; const bf16x2_t b = __builtin_convertvector(v, bf16x2_t); return __builtin_bit_cast(unsigned, b); }
__device__ __forceinline__ bf16_t f2bf(float f) { return (bf16_t)(cvt_pk_bf16(f, 0.f) & 0xffffu); }
__device__ __forceinline__ float bf2f(bf16_t b) { return __uint_as_float(((unsigned)b) << 16); }
__device__ __forceinline__ float bflo(unsigned u) { return __uint_as_float(u << 16); }
__device__ __forceinline__ float bfhi(unsigned u) { return __uint_as_float(u & 0xffff0000u); }
__device__ __forceinline__ float sigmoidf_(float x) { return __builtin_amdgcn_rcpf(1.0f + __expf(-x)); }
__device__ __forceinline__ float clampe(float x) { return fminf(fmaxf(x, -80.f), 80.f); }
__device__ __forceinline__ f32x2 gelu_pk(f32x2 v) {
    const f32x2 av = __builtin_elementwise_abs(v), d = av * 0.2316418882f + 1.0f;
    f32x2 t; t.x = __builtin_amdgcn_rcpf(d.x); t.y = __builtin_amdgcn_rcpf(d.y);
    f32x2 q = t * 0.5307027145f + (-0.7265760135f); q = q * t + 0.7107068705f; q = q * t + (-0.142248368f); q = q * t + 0.127414796f; q = q * t;
    const f32x2 s = (v * v) * (-0.72134752044f);
    f32x2 e; e.x = __builtin_amdgcn_exp2f(s.x); e.y = __builtin_amdgcn_exp2f(s.y);
    return av * (0.5f - q * e) + 0.5f * v;
}
__device__ __forceinline__ float gelu1(float x) { f32x2 r = gelu_pk((f32x2){x, 0.f}); return r.x; }
__device__ __forceinline__ f32x4 gelu4(f32x4 v) { f32x2 a = gelu_pk((f32x2){v[0], v[1]}), b = gelu_pk((f32x2){v[2], v[3]}); return (f32x4){a.x, a.y, b.x, b.y}; }
__device__ __forceinline__ u32x2 pack4(f32x4 v) { u32x2 w; w.x = cvt_pk_bf16(v[0], v[1]); w.y = cvt_pk_bf16(v[2], v[3]); return w; }
__device__ __forceinline__ f32x4 unpack4(u32x2 w) { return (f32x4){bflo(w.x), bfhi(w.x), bflo(w.y), bfhi(w.y)}; }
__device__ __forceinline__ bf16x8 ldfrag(const LAS bf16_t* p) { return *(const LAS bf16x8*)p; }
__device__ __forceinline__ f32x4 zero4() { return (f32x4){0.f, 0.f, 0.f, 0.f}; }
__device__ __forceinline__ float row_rstd(const float* ssp, int row) {
    const f32x4* q = (const f32x4*)(ssp + (size_t)row * 16);
    const f32x4 a = q[0], b = q[1], c = q[2], d = q[3];
    const float t = (((a[0] + a[1]) + (a[2] + a[3])) + ((b[0] + b[1]) + (b[2] + b[3]))) + (((c[0] + c[1]) + (c[2] + c[3])) + ((d[0] + d[1]) + (d[2] + d[3])));
    return __builtin_amdgcn_rsqf(t * (1.0f / 1024.0f) + EPS);
}
__device__ __forceinline__ float row_rstd_q(const float* ssp, int row, int fq) {
    const f32x4 a = *(const f32x4*)(ssp + (size_t)row * 16 + 4 * fq);
    float t = (a[0] + a[1]) + (a[2] + a[3]);
    t += __shfl_xor(t, 16); t += __shfl_xor(t, 32);
    return __builtin_amdgcn_rsqf(t * (1.0f / 1024.0f) + EPS);
}
#define MFMA16(a, b, c) __builtin_amdgcn_mfma_f32_16x16x32_bf16((a), (b), (c), 0, 0, 0)

namespace pg8 {
constexpr int BM = 256, BK = 64, HALF = 128, HTB = HALF * BK * 2, STAGE_BYTES = 8 * HTB, NXCD = 8, WGM = 8;
__device__ __forceinline__ int lds_byte(int r, int c) { const int st = (r >> 4) * 2 + (c >> 5), rr = r & 15, cc = c & 31, ob = rr * 64 + cc * 2; return st * 1024 + (ob ^ (((ob >> 9) & 1) << 5)); }
__device__ __forceinline__ void stage_rc(int b, int& R, int& C) { const int st = b / 1024, sb = b % 1024, swz = sb ^ (((sb >> 9) & 1) << 5); R = (st >> 1) * 16 + swz / 64; C = (st & 1) * 32 + (swz % 64) / 2; }
__device__ __forceinline__ int perm32(int rho) { const int n = rho >> 4, i = rho & 15; return 8 * (i >> 2) + 4 * n + (i & 3); }
struct Unit { int pm, pn; };
struct Gemm { const bf16_t* A; const bf16_t* Bt; int M, N, K, lda; };
struct StaticOrder {
    int nM, nN, nwg, G, c;
    __device__ void init(int M, int N, int G_, int c_) { nM = M / BM; nN = N / BM; nwg = nM * nN; G = G_; c = c_; }
    __device__ bool next(int i, Unit& u) const {
        const long L = (long)i * G + c; if (L >= nwg) return false;
        int wgid = (int)L; { const int q = nwg / NXCD, r = nwg % NXCD, xcd = wgid % NXCD, off = wgid / NXCD; wgid = (xcd < r ? xcd * (q + 1) : r * (q + 1) + (xcd - r) * q) + off; }
        const int nig = WGM * nN, gid = wgid / nig, fm = gid * WGM, gsz = (nM - fm) < WGM ? (nM - fm) : WGM;
        u.pm = fm + ((wgid % nig) % gsz); u.pn = (wgid % nig) / gsz; return true;
    }
};

template <class Epi>
__device__ __forceinline__ void gemm_phase(LAS unsigned char* lds, const Gemm g, const StaticOrder& S, const Epi& E) {
    const int tid = fresh_tid(), wid = __builtin_amdgcn_readfirstlane(tid >> 6), lane = tid & 63, wr = wid >> 2, wc = wid & 3, fr = lane & 15, fq = lane >> 4;
    const int K = g.K, nt = K / BK;
    unsigned voffA[2], voffB[2];
#pragma unroll
    for (int i = 0; i < 2; ++i) { int R, C; stage_rc(tid * 16 + i * 8192, R, C); const int Rb = Epi::PERM ? ((R & ~31) + perm32(R & 31)) : R;
        const int Ra = Epi::ROWSPLIT ? ((R >> 6) * 128 + (R & 63)) : R;
        voffA[i] = (unsigned)(Ra * g.lda + C) * 2u; voffB[i] = (unsigned)(Rb * K + C) * 2u; }
    const size_t kstep = (size_t)(BK * 2);
    const size_t hstepA = (size_t)(Epi::ROWSPLIT ? 64 : HALF) * g.lda * 2, hstepB = (size_t)HALF * K * 2;
    const size_t tstepA = (size_t)BM * g.lda * 2, tstepB = 2 * hstepB;
    const unsigned ldsw = (unsigned)wid * 1024u;
    const int aoff = lds_byte(wr * 64 + fr, fq * 8), boff = lds_byte(wc * 32 + fr, fq * 8);
#define PG8_SA(b, h) (((b) * 2 + (h)) * HTB)
#define PG8_SB(b, h) ((4 + (b) * 2 + (h)) * HTB)
#define PG8_STAGE(bufoff, gbase, voff) do { _Pragma("unroll") for (int _i = 0; _i < 2; ++_i) \
        __builtin_amdgcn_global_load_lds((const unsigned*)((const char*)(gbase) + (voff)[_i]), (LAS unsigned*)(lds + (bufoff) + ldsw + _i * 8192), 16, 0, 0); } while (0)
#define PG8_LDA(dst, b, h) do { _Pragma("unroll") for (int m = 0; m < 4; ++m) _Pragma("unroll") for (int k = 0; k < 2; ++k) dst[m][k] = *(const LAS bf16x8*)(lds + PG8_SA(b, h) + aoff + m * 2048 + k * 1024); } while (0)
#define PG8_LDB(dst, b, h) do { _Pragma("unroll") for (int n = 0; n < 2; ++n) _Pragma("unroll") for (int k = 0; k < 2; ++k) dst[n][k] = *(const LAS bf16x8*)(lds + PG8_SB(b, h) + boff + n * 2048 + k * 1024); } while (0)
#define PG8_MMA(ai, bj, At, Bt) do { __builtin_amdgcn_s_setprio(1); _Pragma("unroll") for (int m = 0; m < 4; ++m) _Pragma("unroll") for (int n = 0; n < 2; ++n) _Pragma("unroll") for (int k = 0; k < 2; ++k) \
        acc[ai][bj][m][n] = __builtin_amdgcn_mfma_f32_16x16x32_bf16(Bt[n][k], At[m][k], acc[ai][bj][m][n], 0, 0, 0); __builtin_amdgcn_s_setprio(0); } while (0)
#define PG8_WAIT_V(n) asm volatile("s_waitcnt vmcnt(" #n ")" ::: "memory")
#define PG8_WAIT_L(n) asm volatile("s_waitcnt lgkmcnt(" #n ")" ::: "memory")
#define PG8_BAR __builtin_amdgcn_s_barrier()
#define PG8_SCHED __builtin_amdgcn_sched_barrier(0)
    Unit cur, nxt; int ui = 0;
    if (!S.next(0, cur)) return;
    f32x4 acc[2][2][4][2];
#pragma unroll
    for (int a = 0; a < 2; ++a)
#pragma unroll
        for (int b = 0; b < 2; ++b)
#pragma unroll
            for (int m = 0; m < 4; ++m)
#pragma unroll
                for (int n = 0; n < 2; ++n) acc[a][b][m][n] = (f32x4){0.f, 0.f, 0.f, 0.f};
    bf16x8 At[4][2], B0[2][2], B1[2][2];
    const char* cA = (const char*)g.A + (size_t)cur.pm * tstepA; const char* cB = (const char*)g.Bt + (size_t)cur.pn * tstepB;
    PG8_STAGE(PG8_SB(0, 0), cB, voffB); PG8_STAGE(PG8_SA(0, 0), cA, voffA); PG8_STAGE(PG8_SB(0, 1), cB + hstepB, voffB); PG8_STAGE(PG8_SA(0, 1), cA + hstepA, voffA);
    if (wr == 1) PG8_BAR;
    PG8_WAIT_V(4); PG8_BAR;
    PG8_STAGE(PG8_SB(1, 0), cB + kstep, voffB); PG8_STAGE(PG8_SA(1, 0), cA + kstep, voffA); PG8_STAGE(PG8_SB(1, 1), cB + hstepB + kstep, voffB);
    PG8_WAIT_V(6); PG8_BAR;
    for (;;) {
        const bool has_next = S.next(ui + 1, nxt);
        const char* nA = has_next ? (const char*)g.A + (size_t)nxt.pm * tstepA : cA; const char* nB = has_next ? (const char*)g.Bt + (size_t)nxt.pn * tstepB : cB;
        for (int t = 0; t < nt; t += 2) {
            const bool last = (t == nt - 2);
            const char* a1 = cA + (size_t)(t + 1) * kstep;
            const char* a2 = last ? nA : cA + (size_t)(t + 2) * kstep; const char* b2 = last ? nB : cB + (size_t)(t + 2) * kstep;
            const char* a3 = a2 + kstep; const char* b3 = b2 + kstep;
            PG8_LDB(B0, 0, 0); PG8_SCHED; PG8_LDA(At, 0, 0); PG8_STAGE(PG8_SA(1, 1), a1 + hstepA, voffA);
            PG8_WAIT_L(8); PG8_BAR; PG8_WAIT_L(0); PG8_MMA(0, 0, At, B0); PG8_BAR; PG8_SCHED;
            PG8_LDB(B1, 0, 1); PG8_STAGE(PG8_SB(0, 0), b2, voffB);
            PG8_BAR; PG8_WAIT_L(0); PG8_MMA(0, 1, At, B1); PG8_BAR;
            PG8_LDA(At, 0, 1); PG8_STAGE(PG8_SA(0, 0), a2, voffA);
            PG8_BAR; PG8_WAIT_L(0); PG8_MMA(1, 0, At, B0); PG8_BAR; PG8_SCHED;
            PG8_STAGE(PG8_SB(0, 1), b2 + hstepB, voffB);
            PG8_WAIT_V(6); PG8_BAR; PG8_MMA(1, 1, At, B1); PG8_BAR;
            PG8_LDB(B0, 1, 0); PG8_SCHED; PG8_LDA(At, 1, 0); PG8_STAGE(PG8_SA(0, 1), a2 + hstepA, voffA);
            PG8_WAIT_L(8); PG8_BAR; PG8_WAIT_L(0); PG8_MMA(0, 0, At, B0); PG8_BAR; PG8_SCHED;
            PG8_LDB(B1, 1, 1); PG8_STAGE(PG8_SB(1, 0), b3, voffB);
            PG8_BAR; PG8_WAIT_L(0); PG8_MMA(0, 1, At, B1); PG8_BAR;
            PG8_LDA(At, 1, 1); PG8_STAGE(PG8_SA(1, 0), a3, voffA);
            PG8_BAR; PG8_WAIT_L(0); PG8_MMA(1, 0, At, B0); PG8_BAR; PG8_SCHED;
            PG8_STAGE(PG8_SB(1, 1), b3 + hstepB, voffB);
            PG8_WAIT_V(6); PG8_BAR; PG8_MMA(1, 1, At, B1); PG8_BAR;
        }
        E(acc, cur, wr, wc, fr, fq);
        if (!has_next) break;
#pragma unroll
        for (int a = 0; a < 2; ++a)
#pragma unroll
            for (int b = 0; b < 2; ++b)
#pragma unroll
                for (int m = 0; m < 4; ++m)
#pragma unroll
                    for (int n = 0; n < 2; ++n) acc[a][b][m][n] = (f32x4){0.f, 0.f, 0.f, 0.f};
        cur = nxt; cA = nA; cB = nB; ++ui;
    }
    PG8_WAIT_V(0);
    if (wr == 0) PG8_BAR;
    PG8_BAR;
#undef PG8_SA
#undef PG8_SB
#undef PG8_STAGE
#undef PG8_LDA
#undef PG8_LDB
#undef PG8_MMA
#undef PG8_WAIT_V
#undef PG8_WAIT_L
#undef PG8_BAR
#undef PG8_SCHED
}
}
using pg8::Unit;
typedef f32x4 Acc[2][2][4][2];

struct EpiAB {
    static constexpr bool PERM = true, ROWSPLIT = false;
    bf16_t* PROJ; float* LF; const float* ssin; const float* lb;
    __device__ __forceinline__ void operator()(const Acc& acc, const Unit& u, int wr, int wc, int fr, int fq) const {
        const int seg = u.pn >> 1;
        const int row0 = u.pm * 256 + wr * 64 + fr, col0 = u.pn * 256 + wc * 32 + 8 * fq;
        float rsv[8];
#pragma unroll
        for (int g = 0; g < 8; ++g) rsv[g] = row_rstd_q(ssin, row0 + (g >> 2) * 128 + (g & 3) * 16, fq);
#pragma unroll
        for (int ai = 0; ai < 2; ++ai)
#pragma unroll
            for (int m = 0; m < 4; ++m) {
                const int row = row0 + ai * 128 + m * 16;
                const float rs = rsv[ai * 4 + m];
#pragma unroll
                for (int bj = 0; bj < 2; ++bj) {
                    const int col = col0 + bj * 128;
                    f32x4 v0 = acc[ai][bj][m][0] * rs, v1 = acc[ai][bj][m][1] * rs;
                    if (seg == 1) {
                        const f32x4 l0 = *(const f32x4*)(lb + (col - 512)), l1 = *(const f32x4*)(lb + (col - 512) + 4);
                        f32x4 o0, o1;
#pragma unroll
                        for (int j = 0; j < 4; ++j) { o0[j] = __logf(l0[j] + (1.0f - l0[j]) * sigmoidf_(v0[j])); o1[j] = __logf(l1[j] + (1.0f - l1[j]) * sigmoidf_(v1[j])); }
                        *(f32x4*)(LF + (size_t)row * 512 + (col - 512)) = o0;
                        *(f32x4*)(LF + (size_t)row * 512 + (col - 512) + 4) = o1;
                    } else {
                        if (seg == 0) {
#pragma unroll
                            for (int j = 0; j < 4; ++j) { v0[j] = v0[j] * sigmoidf_(v0[j]) * 0.08838834764831845f; v1[j] = v1[j] * sigmoidf_(v1[j]) * 0.08838834764831845f; }
                        } else if (seg == 3) {
#pragma unroll
                            for (int j = 0; j < 4; ++j) { v0[j] = v0[j] * sigmoidf_(v0[j]); v1[j] = v1[j] * sigmoidf_(v1[j]); }
                        }
                        const u32x2 w0 = pack4(v0), w1 = pack4(v1);
                        *(u32x4*)(PROJ + (size_t)row * 2560 + col) = (u32x4){w0.x, w0.y, w1.x, w1.y};
                    }
                }
            }
    }
};
struct EpiRes {
    static constexpr bool PERM = true, ROWSPLIT = false;
    bf16_t* Xb; float* ssout;
    __device__ __forceinline__ void operator()(const Acc& acc, const Unit& u, int wr, int wc, int fr, int fq) const {
        const int row0 = u.pm * 256 + wr * 64 + fr, col0 = u.pn * 256 + wc * 32 + 8 * fq;
        u32x4 bc[2], bn[2];
        { const bf16_t* b = Xb + (size_t)row0 * 1024 + col0; bc[0] = *(const u32x4*)b; bc[1] = *(const u32x4*)(b + 128); }
#pragma unroll
        for (int g = 0; g < 8; ++g) {
            const int row = row0 + (g >> 2) * 128 + (g & 3) * 16;
            if (g < 7) { const bf16_t* b = Xb + (size_t)(row0 + ((g + 1) >> 2) * 128 + ((g + 1) & 3) * 16) * 1024 + col0;
                bn[0] = *(const u32x4*)b; bn[1] = *(const u32x4*)(b + 128); }
            float s = 0.f;
#pragma unroll
            for (int bj = 0; bj < 2; ++bj) {
                const f32x4 x0 = (f32x4){bflo(bc[bj][0]), bfhi(bc[bj][0]), bflo(bc[bj][1]), bfhi(bc[bj][1])} + acc[g >> 2][bj][g & 3][0];
                const f32x4 x1 = (f32x4){bflo(bc[bj][2]), bfhi(bc[bj][2]), bflo(bc[bj][3]), bfhi(bc[bj][3])} + acc[g >> 2][bj][g & 3][1];
                const u32x2 w0 = pack4(x0), w1 = pack4(x1);
                *(u32x4*)(Xb + (size_t)row * 1024 + col0 + bj * 128) = (u32x4){w0.x, w0.y, w1.x, w1.y};
                s += ((x0[0] * x0[0] + x0[1] * x0[1]) + (x0[2] * x0[2] + x0[3] * x0[3])) + ((x1[0] * x1[0] + x1[1] * x1[1]) + (x1[2] * x1[2] + x1[3] * x1[3]));
            }
            s += __shfl_xor(s, 16); s += __shfl_xor(s, 32);
            if (fq == 0) ssout[(size_t)row * 16 + u.pn * 4 + wc] = s;
            bc[0] = bn[0]; bc[1] = bn[1];
        }
    }
};
struct EpiUV {
    static constexpr bool PERM = true, ROWSPLIT = false;
    bf16_t* UV; const float* ssin; float* vst;
    __device__ __forceinline__ void operator()(const Acc& acc, const Unit& u, int wr, int wc, int fr, int fq) const {
        const bool isv = u.pn >= 8;
        const int row0 = u.pm * 256 + wr * 64 + fr, col0 = u.pn * 256 + wc * 32 + 8 * fq;
        float rsv[8];
#pragma unroll
        for (int g = 0; g < 8; ++g) rsv[g] = row_rstd_q(ssin, row0 + (g >> 2) * 128 + (g & 3) * 16, fq);
#pragma unroll
        for (int ai = 0; ai < 2; ++ai)
#pragma unroll
            for (int m = 0; m < 4; ++m) {
                const int row = row0 + ai * 128 + m * 16;
                const float rs = rsv[ai * 4 + m];
                float s1 = 0.f, s2 = 0.f;
#pragma unroll
                for (int bj = 0; bj < 2; ++bj) {
                    const int col = col0 + bj * 128;
                    const f32x4 z0 = gelu4(acc[ai][bj][m][0] * rs), z1 = gelu4(acc[ai][bj][m][1] * rs);
                    const u32x2 w0 = pack4(z0), w1 = pack4(z1);
                    *(u32x4*)(UV + (size_t)row * 4096 + col) = (u32x4){w0.x, w0.y, w1.x, w1.y};
                    s1 += ((z0[0] + z0[1]) + (z0[2] + z0[3])) + ((z1[0] + z1[1]) + (z1[2] + z1[3]));
                    s2 += ((z0[0] * z0[0] + z0[1] * z0[1]) + (z0[2] * z0[2] + z0[3] * z0[3])) + ((z1[0] * z1[0] + z1[1] * z1[1]) + (z1[2] * z1[2] + z1[3] * z1[3]));
                }
                if (isv) {
                    s1 += __shfl_xor(s1, 16); s1 += __shfl_xor(s1, 32);
                    s2 += __shfl_xor(s2, 16); s2 += __shfl_xor(s2, 32);
                    if (fq == 0) { f32x2 pr = {s1, s2}; *(f32x2*)(vst + (size_t)row * 64 + ((u.pn - 8) * 4 + wc) * 2) = pr; }
                }
            }
    }
};
struct EpiFF1 {
    static constexpr bool PERM = true, ROWSPLIT = false;
    bf16_t* BIG; const float* ssin;
    __device__ __forceinline__ void operator()(const Acc& acc, const Unit& u, int wr, int wc, int fr, int fq) const {
        const int row0 = u.pm * 256 + wr * 64 + fr, col0 = u.pn * 256 + wc * 32 + 8 * fq;
        float rsv[8];
#pragma unroll
        for (int g = 0; g < 8; ++g) rsv[g] = row_rstd_q(ssin, row0 + (g >> 2) * 128 + (g & 3) * 16, fq);
#pragma unroll
        for (int ai = 0; ai < 2; ++ai)
#pragma unroll
            for (int m = 0; m < 4; ++m) {
                const int row = row0 + ai * 128 + m * 16;
                const float rs = rsv[ai * 4 + m];
#pragma unroll
                for (int bj = 0; bj < 2; ++bj) {
                    const u32x2 w0 = pack4(acc[ai][bj][m][0] * rs), w1 = pack4(acc[ai][bj][m][1] * rs);
                    *(u32x4*)(BIG + (size_t)row * 5632 + col0 + bj * 128) = (u32x4){w0.x, w0.y, w1.x, w1.y};
                }
            }
    }
};


struct EpiFF2 {
    static constexpr bool PERM = true, ROWSPLIT = true;
    bf16_t* Y; float* EDGE; const float* ssin; const float* cw; const float* cb;
    __device__ __forceinline__ void operator()(const Acc& acc, const Unit& u, int wr, int wc, int fr, int fq) const {
        const int cl = wc * 32 + 8 * fq, c = u.pn * 128 + cl;
        const int row0 = u.pm * 256 + wr * 128 + fr;
        const unsigned ybase = (unsigned)row0 * 2816u + (unsigned)c;
        float rsv[8];
#pragma unroll
        for (int g = 0; g < 8; ++g) rsv[g] = row_rstd_q(ssin, row0 + (g >> 2) * 64 + (g & 3) * 16, fq);
#pragma unroll
        for (int h = 0; h < 2; ++h) {
            const f32x4 w0 = *(const f32x4*)(cw + c + 4 * h), w1 = *(const f32x4*)(cw + 2816 + c + 4 * h), w2 = *(const f32x4*)(cw + 5632 + c + 4 * h), bs = *(const f32x4*)(cb + c + 4 * h);
            f32x4 prev = (f32x4){0.f, 0.f, 0.f, 0.f};
#pragma unroll
            for (int ai = 0; ai < 2; ++ai)
#pragma unroll
                for (int m = 0; m < 4; ++m) {
                    const float rs = rsv[ai * 4 + m];
                    const f32x4 cur = acc[ai][0][m][h] * rs, gt = acc[ai][1][m][h] * rs;
                    f32x4 p1, p2;
#pragma unroll
                    for (int j = 0; j < 4; ++j) {
                        const float m1 = (fr == 15) ? prev[j] : cur[j], m2 = (fr >= 14) ? prev[j] : cur[j];
                        p1[j] = __builtin_bit_cast(float, __builtin_amdgcn_mov_dpp(__builtin_bit_cast(int, m1), 0x121, 0xf, 0xf, true));
                        p2[j] = __builtin_bit_cast(float, __builtin_amdgcn_mov_dpp(__builtin_bit_cast(int, m2), 0x122, 0xf, 0xf, true));
                    }
                    const f32x4 ge = gelu4(bs + w0 * p2 + w1 * p1 + w2 * cur);
                    *(u32x2*)(Y + (ybase + (unsigned)((ai * 64 + m * 16) * 2816 + 4 * h))) = pack4(ge * gt);
                    prev = cur;
                }
        }
        if (fr < 2) {
            const f32x4 a0 = acc[0][0][0][0] * rsv[0], a1 = acc[0][0][0][1] * rsv[0], g0 = acc[0][1][0][0] * rsv[0], g1 = acc[0][1][0][1] * rsv[0];
            float* ep = EDGE + ((size_t)u.pm * 12 + wr * 6 + fr) * 2816 + c; *(f32x4*)ep = a0; *(f32x4*)(ep + 4) = a1;
            float* gp = EDGE + ((size_t)u.pm * 12 + wr * 6 + 2 + fr) * 2816 + c; *(f32x4*)gp = g0; *(f32x4*)(gp + 4) = g1;
        }
        if (fr >= 14) {
            const f32x4 a0 = acc[1][0][3][0] * rsv[7], a1 = acc[1][0][3][1] * rsv[7];
            float* ep = EDGE + ((size_t)u.pm * 12 + wr * 6 + 4 + (fr - 14)) * 2816 + c; *(f32x4*)ep = a0; *(f32x4*)(ep + 4) = a1;
        }
    }
};
struct SEpiFF2 {
    bf16_t* SBUF; const float* ssin;
    __device__ __forceinline__ void operator()(f32x4 v, int row, int col, int sl, int l16) const {
        const int orig = ((col >> 7) & 1) * 2816 + (col >> 8) * 128 + (col & 127);
        *(u32x2*)(SBUF + (size_t)(row - MP) * 5632 + orig) = pack4(v * row_rstd(ssin, row));
    }
};

constexpr int SPS = 68;
template <class Epi>
__device__ __forceinline__ void sample_gemm(LAS unsigned char* lds, const bf16_t* A, int lda, const bf16_t* Bt, int K, int N, const Epi& E) {
    const int tid = fresh_tid(), lane = tid & 63, w = tid >> 6, fr = lane & 15, fq = lane >> 4;
    LAS float* P = (LAS float*)lds;
    const int nslab = N >> 6, nitems = nslab * 8, kw = K >> 3, kbeg = w * kw;
    for (int it = blockIdx.x; it < nitems; it += gridDim.x) {
        const int sl = it >> 3, r0 = (it & 7) * 32, n0 = sl * 64;
        f32x4 acc[2][4];
#pragma unroll
        for (int i = 0; i < 2; ++i)
#pragma unroll
            for (int j = 0; j < 4; ++j) acc[i][j] = (f32x4){0.f, 0.f, 0.f, 0.f};
        const bf16_t* ap = A + (size_t)(r0 + fr) * lda + kbeg + 8 * fq;
        const bf16_t* bp = Bt + (size_t)(n0 + fr) * K + kbeg + 8 * fq;
#pragma unroll 4
        for (int ks = 0; ks < kw; ks += 32) {
            const bf16x8 a0 = *(const bf16x8*)(ap + ks), a1 = *(const bf16x8*)(ap + (size_t)16 * lda + ks);
            bf16x8 b[4];
#pragma unroll
            for (int j = 0; j < 4; ++j) b[j] = *(const bf16x8*)(bp + (size_t)j * 16 * K + ks);
#pragma unroll
            for (int j = 0; j < 4; ++j) { acc[0][j] = MFMA16(b[j], a0, acc[0][j]); acc[1][j] = MFMA16(b[j], a1, acc[1][j]); }
        }
#pragma unroll
        for (int i = 0; i < 2; ++i)
#pragma unroll
            for (int j = 0; j < 4; ++j) *(LAS f32x4*)(P + (w * 32 + 16 * i + fr) * SPS + 16 * j + 4 * fq) = acc[i][j];
        __syncthreads();
        const int r = tid >> 4, c4 = (tid & 15) * 4;
        f32x4 v = *(const LAS f32x4*)(P + r * SPS + c4);
#pragma unroll
        for (int ww = 1; ww < 8; ++ww) v += *(const LAS f32x4*)(P + (ww * 32 + r) * SPS + c4);
        E(v, MP + r0 + r, n0 + c4, sl, tid & 15);
        __syncthreads();
    }
}
struct SEpiAB {
    bf16_t* PROJ; float* LF; const float* ssin; const float* lb;
    __device__ __forceinline__ void operator()(f32x4 v, int row, int col, int sl, int l16) const {
        const int seg = col >> 9;
        v = v * row_rstd(ssin, row);
        if (seg == 1) {
            const f32x4 l = *(const f32x4*)(lb + (col - 512));
            f32x4 o;
#pragma unroll
            for (int q = 0; q < 4; ++q) { const float f = l[q] + (1.0f - l[q]) * sigmoidf_(v[q]); o[q] = __logf(f); }
            *(f32x4*)(LF + (size_t)row * 512 + (col - 512)) = o;
        } else {
            if (seg == 0) {
#pragma unroll
                for (int q = 0; q < 4; ++q) v[q] = v[q] * sigmoidf_(v[q]) * 0.08838834764831845f;
            } else if (seg == 3) {
#pragma unroll
                for (int q = 0; q < 4; ++q) v[q] = v[q] * sigmoidf_(v[q]);
            }
            *(u32x2*)(PROJ + (size_t)row * 2560 + col) = pack4(v);
        }
    }
};
struct SEpiRes {
    bf16_t* Xb; float* ssout;
    __device__ __forceinline__ void operator()(f32x4 v, int row, int col, int sl, int l16) const {
        bf16_t* xp = Xb + (size_t)row * 1024 + col;
        const f32x4 x = unpack4(*(const u32x2*)xp) + v;
        *(u32x2*)xp = pack4(x);
        float s = (x[0] * x[0] + x[1] * x[1]) + (x[2] * x[2] + x[3] * x[3]);
        s += __shfl_xor(s, 1); s += __shfl_xor(s, 2); s += __shfl_xor(s, 4); s += __shfl_xor(s, 8);
        if (l16 == 0) ssout[(size_t)row * 16 + sl] = s;
    }
};
struct SEpiUV {
    bf16_t* UV; const float* ssin; float* vst;
    __device__ __forceinline__ void operator()(f32x4 v, int row, int col, int sl, int l16) const {
        const f32x4 z = gelu4(v * row_rstd(ssin, row));
        *(u32x2*)(UV + (size_t)row * 4096 + col) = pack4(z);
        if (col >= 2048) {
            float s1 = (z[0] + z[1]) + (z[2] + z[3]), s2 = (z[0] * z[0] + z[1] * z[1]) + (z[2] * z[2] + z[3] * z[3]);
            s1 += __shfl_xor(s1, 1); s1 += __shfl_xor(s1, 2); s1 += __shfl_xor(s1, 4); s1 += __shfl_xor(s1, 8);
            s2 += __shfl_xor(s2, 1); s2 += __shfl_xor(s2, 2); s2 += __shfl_xor(s2, 4); s2 += __shfl_xor(s2, 8);
            if (l16 == 0) { f32x2 pr = {s1, s2}; *(f32x2*)(vst + (size_t)row * 64 + (sl - 32) * 2) = pr; }
        }
    }
};
struct SEpiFF1 {
    bf16_t* BIG; const float* ssin;
    __device__ __forceinline__ void operator()(f32x4 v, int row, int col, int sl, int l16) const {
        *(u32x2*)(BIG + (size_t)row * 5632 + col) = pack4(v * row_rstd(ssin, row));
    }
};

__device__ __forceinline__ void convT(LAS unsigned char* lds, const float* W, int K, int N, const float* gain, bf16_t* Bt, int ldb, int rot, bool ffperm = false) {
    LAS float* tile = (LAS float*)lds;
    const int tid = fresh_tid(), nb = gridDim.x;
    const int ntn = N >> 8, ntiles = (K >> 6) * ntn;
    const int start = (int)((blockIdx.x + nb - (rot % nb)) % nb);
    const int li = tid >> 6, c4 = (tid & 63) * 4;
    f32x4 v[8]; float gg[8];
    if (start < ntiles) { const int k0 = (start / ntn) << 6, n0 = (start % ntn) << 8;
#pragma unroll
        for (int ps = 0; ps < 8; ++ps) { v[ps] = *(const f32x4*)(W + (size_t)(k0 + ps * 8 + li) * N + n0 + c4); gg[ps] = gain ? gain[k0 + ps * 8 + li] : 1.0f; } }
    for (int t = start; t < ntiles; t += nb) {
        const int k0 = (t / ntn) << 6, n0 = (t % ntn) << 8;
#pragma unroll
        for (int ps = 0; ps < 8; ++ps) {
            const int i = ps * 8 + li;
#pragma unroll
            for (int j = 0; j < 4; ++j) tile[i * 257 + c4 + j] = v[ps][j] * gg[ps];
        }
        __syncthreads();
        if (t + nb < ntiles) { const int k1 = ((t + nb) / ntn) << 6, n1 = ((t + nb) % ntn) << 8;
#pragma unroll
            for (int ps = 0; ps < 8; ++ps) { v[ps] = *(const f32x4*)(W + (size_t)(k1 + ps * 8 + li) * N + n1 + c4); gg[ps] = gain ? gain[k1 + ps * 8 + li] : 1.0f; } }
        const int n = tid >> 1, ks = (tid & 1) * 32;
        const int nb128 = n0 + (n & 128);
        const int n0p = ffperm ? ((nb128 < 2816) ? 2 * nb128 : 2 * (nb128 - 2816) + 128) : nb128;
        bf16_t* dst = Bt + (size_t)(n0p + (n & 127)) * ldb + k0 + ks;
#pragma unroll
        for (int q = 0; q < 4; ++q) {
            unsigned w[4];
#pragma unroll
            for (int j = 0; j < 4; ++j) w[j] = cvt_pk_bf16(tile[(ks + q * 8 + 2 * j) * 257 + n], tile[(ks + q * 8 + 2 * j + 1) * 257 + n]);
            *(u32x4*)(dst + q * 8) = (u32x4){w[0], w[1], w[2], w[3]};
        }
        __syncthreads();
    }
}
__device__ __forceinline__ void fold_pool(LAS unsigned char* lds, const float* pool_w, const float* pool_scale, const float* w_out, bf16_t* Bt2, int rot) {
    LAS float* pw = (LAS float*)lds;
    const int tid = fresh_tid(), nb = gridDim.x;
    const int start = (int)((blockIdx.x + nb - (rot % nb)) % nb);
    for (int item = start; item < 128; item += nb) {
        const int g = item >> 5, d0 = (item & 31) * 32;
        for (int i = 0; i < 32; ++i) { const int idx = tid + i * 512, c = idx >> 7, e = idx & 127; pw[c * 129 + e] = pool_w[(size_t)(g * 128 + c) * 128 + e] * pool_scale[g * 128 + e]; }
        __syncthreads();
        const int c = tid & 127, dbase = d0 + (tid >> 7) * 8;
        float a0 = 0.f, a1 = 0.f, a2 = 0.f, a3 = 0.f, a4 = 0.f, a5 = 0.f, a6 = 0.f, a7 = 0.f;
        for (int e = 0; e < 128; ++e) {
            const float a = pw[c * 129 + e];
            const float* wrp = w_out + (size_t)(512 + g * 128 + e) * 1024 + dbase;
            const f32x4 w0 = *(const f32x4*)wrp, w1 = *(const f32x4*)(wrp + 4);
            a0 += a * w0[0]; a1 += a * w0[1]; a2 += a * w0[2]; a3 += a * w0[3];
            a4 += a * w1[0]; a5 += a * w1[1]; a6 += a * w1[2]; a7 += a * w1[3];
        }
        bf16_t* dst = Bt2 + (size_t)dbase * 1024 + 512 + g * 128 + c;
        dst[0] = f2bf(a0); dst[1024] = f2bf(a1); dst[2048] = f2bf(a2); dst[3072] = f2bf(a3);
        dst[4096] = f2bf(a4); dst[5120] = f2bf(a5); dst[6144] = f2bf(a6); dst[7168] = f2bf(a7);
        __syncthreads();
    }
}
__device__ __forceinline__ void prep_layer(const Params& p, LAS unsigned char* lds, int l) {
    bf16_t* slot = (bf16_t*)(p.ws + WS_W0 + (size_t)(l & 1) * SLOT_BYTES);
    const int h = l >> 1;
    size_t ffo_in, ffo_out;
    if ((l & 1) == 0) {
        convT(lds, p.in[9] + (size_t)h * 1024 * 2560, 1024, 2560, p.in[5] + l * 1024, slot, 1024, 0);
        convT(lds, p.in[13] + (size_t)h * 1024 * 1024, 512, 1024, nullptr, slot + 2621440, 1024, 320);
        fold_pool(lds, p.in[11] + (size_t)h * 4 * 128 * 128, p.in[12] + h * 512, p.in[13] + (size_t)h * 1024 * 1024, slot + 2621440, 384);
        ffo_in = 3670016; ffo_out = 9437184;
    } else {
        convT(lds, p.in[14] + (size_t)h * 1024 * 4096, 1024, 4096, p.in[5] + l * 1024, slot, 1024, 0);
        convT(lds, p.in[19] + (size_t)h * 2048 * 1024, 2048, 1024, nullptr, slot + 4194304, 2048, 0);
        ffo_in = 6291456; ffo_out = 12058624;
    }
    convT(lds, p.in[20] + (size_t)l * 1024 * 5632, 1024, 5632, p.in[6] + l * 1024, slot + ffo_in, 1024, 0, true);
    convT(lds, p.in[23] + (size_t)l * 2816 * 1024, 2816, 1024, nullptr, slot + ffo_out, 2816, 192);
}

__device__ __forceinline__ void phase0(const Params& p, LAS unsigned char* lds) {
    const int tid = fresh_tid(), bid = blockIdx.x, nb = gridDim.x;
    float* ss = (float*)(p.ws + WS_SS);
    if (bid == 0) {
        float* lb = (float*)(p.ws + WS_LB); const float* lg = p.in[8];
        for (int k = tid; k < 512; k += NTHR) { const float l0 = lg[k], l1 = lg[512 + k], mx = fmaxf(l0, l1), e0 = expf(l0 - mx), e1 = expf(l1 - mx); lb[k] = 0.f; lb[512 + k] = e1 / (e0 + e1); }
    }
    { bf16_t* Xb = (bf16_t*)(p.ws + WS_XB); const int wave = tid >> 6, lane = tid & 63;
#pragma unroll 2
      for (int row = bid * 8 + wave; row < MA; row += nb * 8) {
          const float* src = row < MP ? p.in[0] + (size_t)row * 1024 : p.in[1] + (size_t)(row - MP) * 1024;
          float s = 0.f;
#pragma unroll
          for (int j = 0; j < 4; ++j) { const f32x4 v = *(const f32x4*)(src + (j * 64 + lane) * 4); s += (v[0] * v[0] + v[1] * v[1]) + (v[2] * v[2] + v[3] * v[3]);
              *(u32x2*)(Xb + (size_t)row * 1024 + (j * 64 + lane) * 4) = pack4(v); }
          for (int o = 32; o >= 1; o >>= 1) s += __shfl_xor(s, o);
          if (lane < 16) ss[(size_t)row * 16 + lane] = (lane == 0) ? s : 0.f;
      } }
    prep_layer(p, lds, 0);
    prep_layer(p, lds, 1);
}

constexpr int BCS = 132;
constexpr int TS = 72;
constexpr int QS = 136;
constexpr int L_BC = 0;
constexpr int L_TOT = 33792;
constexpr int L_KT = 35840;
constexpr int L_VT = 54272;
constexpr int L_QT = 72704;
constexpr int L_K2 = 90112;
constexpr int L_QH = 107520;
constexpr int L_P = 124928;
constexpr int L_SSQ = 35840;

__device__ __forceinline__ void chunk_cumsum(LAS unsigned char* lds, const float* LF, int row0, int h) {
    LAS float* Bc = (LAS float*)(lds + L_BC); LAS float* tot = (LAS float*)(lds + L_TOT);
    const int tid = fresh_tid(), k = tid & 127, part = tid >> 7;
    const float* src = LF + (size_t)(row0 + part * 16) * 512 + h * 128 + k;
    float v[16];
#pragma unroll
    for (int i = 0; i < 16; ++i) v[i] = src[(size_t)i * 512];
    float c = 0.f;
#pragma unroll
    for (int i = 0; i < 16; ++i) { c += v[i]; v[i] = c; }
    tot[part * 128 + k] = c;
    __syncthreads();
    float pre = 0.f;
    if (part > 0) pre += tot[k];
    if (part > 1) pre += tot[128 + k];
    if (part > 2) pre += tot[256 + k];
#pragma unroll
    for (int i = 0; i < 16; ++i) Bc[(part * 16 + i) * BCS + k] = v[i] + pre;
    __syncthreads();
}

__device__ __forceinline__ void hgrn_pass1(const Params& p, LAS unsigned char* lds, int item) {
    const int tid = fresh_tid(), lane = tid & 63, w = tid >> 6;
    const int bh = item >> 6, c = item & 63, b = bh >> 2, h = bh & 3, row0 = b * 4096 + c * 64;
    const bf16_t* PROJ = (const bf16_t*)(p.ws + WS_R + R_PROJ); const float* LF = (const float*)(p.ws + WS_R + R_LF);
    bf16_t* ST = (bf16_t*)(p.ws + WS_R + R_ST); float* DEC = (float*)(p.ws + WS_R + R_DEC);
    LAS float* Bc = (LAS float*)(lds + L_BC); LAS bf16_t* KT = (LAS bf16_t*)(lds + L_KT); LAS bf16_t* VT = (LAS bf16_t*)(lds + L_VT);
    const int s0 = (tid >> 4) * 2, k0 = (tid & 15) * 8;
    const float* lfp = LF + (size_t)(row0 + s0) * 512 + h * 128 + k0;
    const f32x4 la0 = *(const f32x4*)lfp, la1 = *(const f32x4*)(lfp + 4), lb0 = *(const f32x4*)(lfp + 512), lb1 = *(const f32x4*)(lfp + 516);
    const u32x4 va = *(const u32x4*)(PROJ + (size_t)(row0 + s0) * 2560 + 1024 + h * 128 + k0);
    const u32x4 vb = *(const u32x4*)(PROJ + (size_t)(row0 + s0 + 1) * 2560 + 1024 + h * 128 + k0);
    chunk_cumsum(lds, LF, row0, h);
    {
        const f32x4 ba0 = *(const LAS f32x4*)(Bc + s0 * BCS + k0), ba1 = *(const LAS f32x4*)(Bc + s0 * BCS + k0 + 4);
        const f32x4 bb0 = *(const LAS f32x4*)(Bc + (s0 + 1) * BCS + k0), bb1 = *(const LAS f32x4*)(Bc + (s0 + 1) * BCS + k0 + 4);
        const f32x4 e0 = *(const LAS f32x4*)(Bc + 63 * BCS + k0), e1 = *(const LAS f32x4*)(Bc + 63 * BCS + k0 + 4);
#pragma unroll
        for (int j = 0; j < 4; ++j) {
            const float ka0 = (1.0f - __expf(la0[j])) * __expf(e0[j] - ba0[j]), kb0 = (1.0f - __expf(lb0[j])) * __expf(e0[j] - bb0[j]);
            const float ka1 = (1.0f - __expf(la1[j])) * __expf(e1[j] - ba1[j]), kb1 = (1.0f - __expf(lb1[j])) * __expf(e1[j] - bb1[j]);
            *(LAS unsigned*)(KT + (k0 + j) * TS + s0) = cvt_pk_bf16(ka0, kb0);
            *(LAS unsigned*)(KT + (k0 + 4 + j) * TS + s0) = cvt_pk_bf16(ka1, kb1);
            *(LAS unsigned*)(VT + (k0 + 2 * j) * TS + s0) = (va[j] & 0xffffu) | (vb[j] << 16);
            *(LAS unsigned*)(VT + (k0 + 2 * j + 1) * TS + s0) = (va[j] >> 16) | (vb[j] & 0xffff0000u);
        }
    }
    if (tid < 128) DEC[(size_t)item * 128 + tid] = __expf(Bc[63 * BCS + tid]);
    __syncthreads();
    f32x4 acc[8];
#pragma unroll
    for (int j = 0; j < 8; ++j) acc[j] = zero4();
    const int fr = lane & 15, fq = lane >> 4;
#pragma unroll
    for (int kk = 0; kk < 2; ++kk) {
        const bf16x8 a = ldfrag(KT + (16 * w + fr) * TS + 8 * fq + 32 * kk);
#pragma unroll
        for (int jt = 0; jt < 8; ++jt) { const bf16x8 bb = ldfrag(VT + (16 * jt + fr) * TS + 8 * fq + 32 * kk); acc[jt] = MFMA16(a, bb, acc[jt]); }
    }
    bf16_t* dst = ST + (size_t)item * 16384;
#ifdef P1_DBG
#pragma unroll
    for (int jt = 0; jt < 8; ++jt) { const unsigned xk = *(const LAS unsigned*)(KT + (16 * w + fr) * TS + 2 * (jt * 4 + fq)), xv = *(const LAS unsigned*)(VT + (16 * w + fr) * TS + 2 * (jt * 4 + fq));
        acc[jt] = (f32x4){bflo(xk), bfhi(xk), bflo(xv), bfhi(xv)}; }
#endif
#pragma unroll
    for (int jt = 0; jt < 8; ++jt) *(u32x2*)(dst + (16 * jt + fr) * 128 + 16 * w + 4 * fq) = pack4(acc[jt]);
    __syncthreads();
}

__device__ __forceinline__ void hgrn_pass2(const Params& p, int e) {
    bf16_t* ST = (bf16_t*)(p.ws + WS_R + R_ST); const float* DEC = (const float*)(p.ws + WS_R + R_DEC);
    float* outp = p.out + O_HP + (size_t)e * 8 * 4 * 16384;
    for (int g = blockIdx.x * NTHR + fresh_tid(); g < 32 * 4096; g += gridDim.x * NTHR) {
        const int bh = g >> 12, rem = g & 4095, v = rem >> 5, kq = rem & 31;
        f32x4 s = (f32x4){0.f, 0.f, 0.f, 0.f};
        bf16_t* ptr = ST + (size_t)bh * 64 * 16384 + v * 128 + kq * 4;
        const float* dp = DEC + (size_t)bh * 64 * 128 + kq * 4;
#pragma unroll 4
        for (int c = 0; c < 64; ++c) {
            const u32x2 raw = *(const u32x2*)(ptr + (size_t)c * 16384);
            const f32x4 d = *(const f32x4*)(dp + c * 128);
            *(u32x2*)(ptr + (size_t)c * 16384) = pack4(s);
            s = d * s + unpack4(raw);
        }
        float* o = outp + (size_t)bh * 16384 + (kq * 4) * 128 + v;
        o[0] = s[0]; o[128] = s[1]; o[256] = s[2]; o[384] = s[3];
    }
}

__device__ __forceinline__ void hgrn_pass3(const Params& p, LAS unsigned char* lds, int item, int e) {
    const int tid = fresh_tid(), lane = tid & 63, w = tid >> 6, fr = lane & 15, fq = lane >> 4;
    const int bh = item >> 6, c = item & 63, b = bh >> 2, h = bh & 3, row0 = b * 4096 + c * 64;
    const bf16_t* PROJ = (const bf16_t*)(p.ws + WS_R + R_PROJ); const float* LF = (const float*)(p.ws + WS_R + R_LF);
    const bf16_t* ST = (const bf16_t*)(p.ws + WS_R + R_ST) + (size_t)item * 16384;
    bf16_t* A2 = (bf16_t*)(p.ws + WS_R + R_A2);
    LAS float* Bc = (LAS float*)(lds + L_BC); LAS bf16_t* VT = (LAS bf16_t*)(lds + L_VT);
    LAS bf16_t* QT = (LAS bf16_t*)(lds + L_QT); LAS bf16_t* K2 = (LAS bf16_t*)(lds + L_K2); LAS bf16_t* QH = (LAS bf16_t*)(lds + L_QH);
    LAS bf16_t* P = (LAS bf16_t*)(lds + L_P); LAS float* SSQ = (LAS float*)(lds + L_SSQ);
    bf16x8 sfr[4];
#pragma unroll
    for (int kk = 0; kk < 4; ++kk) sfr[kk] = *(const bf16x8*)(ST + (16 * w + fr) * 128 + 8 * fq + 32 * kk);
    f32x4 gl0[2], gl1[2]; u32x4 gqq[2], gvv[2];
#pragma unroll
    for (int it = 0; it < 2; ++it) {
        const int idx = tid + it * 512, s = idx >> 4, k0 = (idx & 15) * 8;
        const float* lfp = LF + (size_t)(row0 + s) * 512 + h * 128 + k0;
        gl0[it] = *(const f32x4*)lfp; gl1[it] = *(const f32x4*)(lfp + 4);
        gqq[it] = *(const u32x4*)(PROJ + (size_t)(row0 + s) * 2560 + h * 128 + k0);
        gvv[it] = *(const u32x4*)(PROJ + (size_t)(row0 + s) * 2560 + 1024 + h * 128 + k0);
    }
    u32x2 gsg[4];
#pragma unroll
    for (int tt = 0; tt < 4; ++tt) gsg[tt] = *(const u32x2*)(PROJ + (size_t)(row0 + 16 * tt + fr) * 2560 + 1536 + h * 128 + 16 * w + 4 * fq);
    chunk_cumsum(lds, LF, row0, h);
#pragma unroll
    for (int it = 0; it < 2; ++it) {
        const int idx = tid + it * 512, s = idx >> 4, k0 = (idx & 15) * 8;
        const f32x4 l0 = gl0[it], l1 = gl1[it];
        const f32x4 b0 = *(const LAS f32x4*)(Bc + s * BCS + k0), b1 = *(const LAS f32x4*)(Bc + s * BCS + k0 + 4);
        const f32x4 r0 = *(const LAS f32x4*)(Bc + 31 * BCS + k0), r1 = *(const LAS f32x4*)(Bc + 31 * BCS + k0 + 4);
        const u32x4 qq = gqq[it];
        const u32x4 vv = gvv[it];
        float q[8] = {bflo(qq[0]), bfhi(qq[0]), bflo(qq[1]), bfhi(qq[1]), bflo(qq[2]), bfhi(qq[2]), bflo(qq[3]), bfhi(qq[3])};
        float bb[8] = {b0[0], b0[1], b0[2], b0[3], b1[0], b1[1], b1[2], b1[3]};
        float rr[8] = {r0[0], r0[1], r0[2], r0[3], r1[0], r1[1], r1[2], r1[3]};
        float ll[8] = {l0[0], l0[1], l0[2], l0[3], l1[0], l1[1], l1[2], l1[3]};
        float qt[8], kt[8], qh[8];
#pragma unroll
        for (int j = 0; j < 8; ++j) {
            const float d = bb[j] - rr[j];
            qt[j] = q[j] * __expf(clampe(d));
            kt[j] = (1.0f - __expf(ll[j])) * __expf(clampe(-d));
            qh[j] = q[j] * __expf(bb[j]);
        }
        *(LAS u32x4*)(QT + s * QS + k0) = (u32x4){cvt_pk_bf16(qt[0], qt[1]), cvt_pk_bf16(qt[2], qt[3]), cvt_pk_bf16(qt[4], qt[5]), cvt_pk_bf16(qt[6], qt[7])};
        *(LAS u32x4*)(K2 + s * QS + k0) = (u32x4){cvt_pk_bf16(kt[0], kt[1]), cvt_pk_bf16(kt[2], kt[3]), cvt_pk_bf16(kt[4], kt[5]), cvt_pk_bf16(kt[6], kt[7])};
        *(LAS u32x4*)(QH + s * QS + k0) = (u32x4){cvt_pk_bf16(qh[0], qh[1]), cvt_pk_bf16(qh[2], qh[3]), cvt_pk_bf16(qh[4], qh[5]), cvt_pk_bf16(qh[6], qh[7])};
        VT[(k0 + 0) * TS + s] = (bf16_t)(vv[0] & 0xffff); VT[(k0 + 1) * TS + s] = (bf16_t)(vv[0] >> 16);
        VT[(k0 + 2) * TS + s] = (bf16_t)(vv[1] & 0xffff); VT[(k0 + 3) * TS + s] = (bf16_t)(vv[1] >> 16);
        VT[(k0 + 4) * TS + s] = (bf16_t)(vv[2] & 0xffff); VT[(k0 + 5) * TS + s] = (bf16_t)(vv[2] >> 16);
        VT[(k0 + 6) * TS + s] = (bf16_t)(vv[3] & 0xffff); VT[(k0 + 7) * TS + s] = (bf16_t)(vv[3] >> 16);
    }
    __syncthreads();
#pragma unroll
    for (int ti = 0; ti < 2; ++ti) {
        const int idx = w + ti * 8, tt = idx >> 2, st = idx & 3;
        f32x4 acc = zero4();
        if (st <= tt) {
#pragma unroll
            for (int kk = 0; kk < 4; ++kk) {
                const bf16x8 a = ldfrag(K2 + (16 * st + fr) * QS + 8 * fq + 32 * kk);
                const bf16x8 bq = ldfrag(QT + (16 * tt + fr) * QS + 8 * fq + 32 * kk);
                acc = MFMA16(a, bq, acc);
            }
            const int t = 16 * tt + fr, s0 = 16 * st + 4 * fq;
#pragma unroll
            for (int j = 0; j < 4; ++j) if (s0 + j > t) acc[j] = 0.f;
        }
        *(LAS u32x2*)(P + (16 * tt + fr) * TS + 16 * st + 4 * fq) = pack4(acc);
    }
    __syncthreads();
    f32x4 oacc[4];
    bf16x8 vfr[2];
#pragma unroll
    for (int kk = 0; kk < 2; ++kk) vfr[kk] = ldfrag(VT + (16 * w + fr) * TS + 8 * fq + 32 * kk);
#pragma unroll
    for (int tt = 0; tt < 4; ++tt) {
        f32x4 acc = zero4();
#pragma unroll
        for (int kk = 0; kk < 2; ++kk) { const bf16x8 bp = ldfrag(P + (16 * tt + fr) * TS + 8 * fq + 32 * kk); acc = MFMA16(vfr[kk], bp, acc); }
#pragma unroll
        for (int kk = 0; kk < 4; ++kk) { const bf16x8 bq = ldfrag(QH + (16 * tt + fr) * QS + 8 * fq + 32 * kk); acc = MFMA16(sfr[kk], bq, acc); }
        oacc[tt] = acc;
        float s = (acc[0] * acc[0] + acc[1] * acc[1]) + (acc[2] * acc[2] + acc[3] * acc[3]);
        s += __shfl_xor(s, 16); s += __shfl_xor(s, 32);
        if (fq == 0) SSQ[(16 * tt + fr) * 8 + w] = s;
    }
    __syncthreads();
    const f32x4 gn = *(const f32x4*)(p.in[10] + e * 128 + 16 * w + 4 * fq);
#pragma unroll
    for (int tt = 0; tt < 4; ++tt) {
        const int t = 16 * tt + fr;
        const f32x4 q0 = *(const LAS f32x4*)(SSQ + t * 8), q1 = *(const LAS f32x4*)(SSQ + t * 8 + 4);
        const float tot = ((q0[0] + q0[1]) + (q0[2] + q0[3])) + ((q1[0] + q1[1]) + (q1[2] + q1[3]));
        const float rs = __builtin_amdgcn_rsqf(tot * (1.0f / 128.0f) + EPS);
        const f32x4 sg = unpack4(gsg[tt]);
        const f32x4 o = oacc[tt] * rs * gn * sg;
        *(u32x2*)(A2 + (size_t)(row0 + t) * 1024 + h * 128 + 16 * w + 4 * fq) = pack4(o);
    }
    __syncthreads();
}

__device__ __forceinline__ void hgrn_sample(const Params& p, LAS unsigned char* lds, int item, int e) {
    const int tid = fresh_tid(), b = item >> 2, h = item & 3, row0 = MP + b * 16;
    const bf16_t* PROJ = (const bf16_t*)(p.ws + WS_R + R_PROJ); const float* LF = (const float*)(p.ws + WS_R + R_LF);
    bf16_t* A2 = (bf16_t*)(p.ws + WS_R + R_A2);
    const float* S0 = p.in[2] + ((size_t)(e * 16 + b) * 4 + h) * 16384;
    float* Sn = p.out + O_HS + ((size_t)(e * 16 + b) * 4 + h) * 16384;
    LAS float* Bs = (LAS float*)lds;
    LAS float* Qs = Bs + 16 * 129;
    LAS float* Ks = Qs + 16 * 129;
    LAS float* Qh = Ks + 16 * 129;
    LAS float* Kh = Qh + 16 * 129;
    LAS float* Vs = Kh + 16 * 129;
    LAS float* Sc = Vs + 16 * 128;
    LAS float* Sq = Sc + 256;
    if (tid < 128) {
        float c = 0.f;
        for (int t = 0; t < 16; ++t) { const float lf = LF[(size_t)(row0 + t) * 512 + h * 128 + tid]; c += lf; Bs[t * 129 + tid] = c; Ks[t * 129 + tid] = 1.0f - __expf(lf); }
    }
    for (int idx = tid; idx < 2048; idx += NTHR) { const int t = idx >> 7, k = idx & 127;
        Qs[t * 129 + k] = bf2f(PROJ[(size_t)(row0 + t) * 2560 + h * 128 + k]);
        Vs[t * 128 + k] = bf2f(PROJ[(size_t)(row0 + t) * 2560 + 1024 + h * 128 + k]); }
    __syncthreads();
    for (int idx = tid; idx < 2048; idx += NTHR) { const int t = idx >> 7, k = idx & 127;
        const float bv = Bs[t * 129 + k];
        Qh[t * 129 + k] = Qs[t * 129 + k] * __expf(bv);
        Kh[t * 129 + k] = Ks[t * 129 + k] * __expf(Bs[15 * 129 + k] - bv); }
    { const int pr = tid >> 1, t = pr >> 4, s = pr & 15, hf = tid & 1;
      float a = 0.f;
      if (s <= t)
#pragma unroll 8
      for (int i = 0; i < 64; ++i) { const int k = hf * 64 + i; a += Qs[t * 129 + k] * Ks[s * 129 + k] * __expf(Bs[t * 129 + k] - Bs[s * 129 + k]); }
      a += __shfl_xor(a, 1);
      if (hf == 0) Sc[t * 16 + s] = a; }
    __syncthreads();
    { const int v = tid & 127, tq = tid >> 7;
      float o0 = 0.f, o1 = 0.f, o2 = 0.f, o3 = 0.f;
#pragma unroll 16
      for (int k = 0; k < 128; ++k) { const float sv = S0[(size_t)k * 128 + v];
          o0 += Qh[(4 * tq + 0) * 129 + k] * sv; o1 += Qh[(4 * tq + 1) * 129 + k] * sv; o2 += Qh[(4 * tq + 2) * 129 + k] * sv; o3 += Qh[(4 * tq + 3) * 129 + k] * sv; }
      for (int s = 0; s < 16; ++s) { const float vv = Vs[s * 128 + v];
          o0 += Sc[(4 * tq + 0) * 16 + s] * vv; o1 += Sc[(4 * tq + 1) * 16 + s] * vv; o2 += Sc[(4 * tq + 2) * 16 + s] * vv; o3 += Sc[(4 * tq + 3) * 16 + s] * vv; }
      float q0 = o0 * o0, q1 = o1 * o1, q2 = o2 * o2, q3 = o3 * o3;
      for (int o = 32; o >= 1; o >>= 1) { q0 += __shfl_xor(q0, o); q1 += __shfl_xor(q1, o); q2 += __shfl_xor(q2, o); q3 += __shfl_xor(q3, o); }
      const int hw = (tid >> 6) & 1;
      if ((tid & 63) == 0) { Sq[(4 * tq + 0) * 2 + hw] = q0; Sq[(4 * tq + 1) * 2 + hw] = q1; Sq[(4 * tq + 2) * 2 + hw] = q2; Sq[(4 * tq + 3) * 2 + hw] = q3; }
      __syncthreads();
      const float gn = p.in[10][e * 128 + v];
      float ov[4] = {o0, o1, o2, o3};
#pragma unroll
      for (int i = 0; i < 4; ++i) { const int t = 4 * tq + i;
          const float rs = __builtin_amdgcn_rsqf((Sq[t * 2] + Sq[t * 2 + 1]) * (1.0f / 128.0f) + EPS);
          const float sg = bf2f(PROJ[(size_t)(row0 + t) * 2560 + 1536 + h * 128 + v]);
          A2[(size_t)(row0 + t) * 1024 + h * 128 + v] = f2bf(ov[i] * rs * gn * sg); }
      float vr[16];
#pragma unroll
      for (int s = 0; s < 16; ++s) vr[s] = Vs[s * 128 + v];
#pragma unroll 8
      for (int kk = 0; kk < 32; ++kk) { const int k = tq * 32 + kk;
          float a = __expf(Bs[15 * 129 + k]) * S0[(size_t)k * 128 + v];
#pragma unroll
          for (int s = 0; s < 16; ++s) a += Kh[s * 129 + k] * vr[s];
          Sn[(size_t)k * 128 + v] = a; }
    }
    __syncthreads();
}

__device__ __forceinline__ void pool_phase(const Params& p, int e) {
    const bf16_t* PROJ = (const bf16_t*)(p.ws + WS_R + R_PROJ); bf16_t* A2 = (bf16_t*)(p.ws + WS_R + R_A2);
    const int nitems = (MA / 16) * 64;
    for (int it = blockIdx.x * NTHR + fresh_tid(); it < nitems; it += gridDim.x * NTHR) {
        const int cgp = it & 63, rr = it >> 6, ch0 = cgp * 8, g = ch0 >> 7, wlen = 2 << g, row0 = rr * 16;
        const bool smp = row0 >= MP;
        const int t0 = smp ? 0 : (row0 & 4095);
        const float* hist = smp ? p.in[3] + ((size_t)(e * 16 + ((row0 - MP) >> 4)) * 15) * 512 + ch0 : nullptr;
        const bf16_t* pb = PROJ + (size_t)row0 * 2560 + 2048 + ch0;
        float sum[8];
#pragma unroll
        for (int j = 0; j < 8; ++j) sum[j] = 0.f;
        for (int d = 1; d < wlen; ++d) {
            const int t = t0 - d;
            if (t >= 0) { const u32x4 q = *(const u32x4*)(pb - (size_t)d * 2560);
                sum[0] += bflo(q[0]); sum[1] += bfhi(q[0]); sum[2] += bflo(q[1]); sum[3] += bfhi(q[1]); sum[4] += bflo(q[2]); sum[5] += bfhi(q[2]); sum[6] += bflo(q[3]); sum[7] += bfhi(q[3]); }
            else if (smp) { const float* hp = hist + (size_t)(15 + t) * 512; const f32x4 a = *(const f32x4*)hp, bq = *(const f32x4*)(hp + 4);
                sum[0] += a[0]; sum[1] += a[1]; sum[2] += a[2]; sum[3] += a[3]; sum[4] += bq[0]; sum[5] += bq[1]; sum[6] += bq[2]; sum[7] += bq[3]; }
        }
#pragma unroll 4
        for (int i = 0; i < 16; ++i) {
            const u32x4 q = *(const u32x4*)(pb + (size_t)i * 2560);
            const float cur[8] = {bflo(q[0]), bfhi(q[0]), bflo(q[1]), bfhi(q[1]), bflo(q[2]), bfhi(q[2]), bflo(q[3]), bfhi(q[3])};
#pragma unroll
            for (int j = 0; j < 8; ++j) sum[j] += cur[j];
            const int t = t0 + i;
            const float cnt = smp ? (float)wlen : (float)((t + 1) < wlen ? (t + 1) : wlen);
            const float inv = 1.0f / cnt;
            float o[8];
#pragma unroll
            for (int j = 0; j < 8; ++j) o[j] = sum[j] * inv - cur[j];
            *(u32x4*)(A2 + (size_t)(row0 + i) * 1024 + 512 + ch0) = (u32x4){cvt_pk_bf16(o[0], o[1]), cvt_pk_bf16(o[2], o[3]), cvt_pk_bf16(o[4], o[5]), cvt_pk_bf16(o[6], o[7])};
            const int td = t - (wlen - 1);
            if (td >= 0) { const u32x4 r = *(const u32x4*)(pb + (ptrdiff_t)(i - (wlen - 1)) * 2560);
                sum[0] -= bflo(r[0]); sum[1] -= bfhi(r[0]); sum[2] -= bflo(r[1]); sum[3] -= bfhi(r[1]); sum[4] -= bflo(r[2]); sum[5] -= bfhi(r[2]); sum[6] -= bflo(r[3]); sum[7] -= bfhi(r[3]); }
            else if (smp) { const float* hp = hist + (size_t)(15 + td) * 512; const f32x4 a = *(const f32x4*)hp, bq = *(const f32x4*)(hp + 4);
                sum[0] -= a[0]; sum[1] -= a[1]; sum[2] -= a[2]; sum[3] -= a[3]; sum[4] -= bq[0]; sum[5] -= bq[1]; sum[6] -= bq[2]; sum[7] -= bq[3]; }
        }
    }
    const int nst = 24 * 15 * 512;
    for (int i = blockIdx.x * NTHR + fresh_tid(); i < nst; i += gridDim.x * NTHR) {
        const int ch = i & 511, r = (i >> 9) % 15, bb = (i >> 9) / 15;
        if (bb < 8) p.out[O_PP + ((size_t)(e * 8 + bb) * 15 + r) * 512 + ch] = bf2f(PROJ[(size_t)(bb * 4096 + 4081 + r) * 2560 + 2048 + ch]);
        else { const int b2 = bb - 8; p.out[O_PS + ((size_t)(e * 16 + b2) * 15 + r) * 512 + ch] = bf2f(PROJ[(size_t)(MP + b2 * 16 + 1 + r) * 2560 + 2048 + ch]); }
    }
}

constexpr int L_VNT = 0;
constexpr int L_WS = 69632;
constexpr int L_MU = 104448;
constexpr int L_RS = 104960;
__device__ __forceinline__ void gate_item(const Params& p, LAS unsigned char* lds, int item, int o) {
    const int tid = fresh_tid(), lane = tid & 63, w = tid >> 6, fr = lane & 15, fq = lane >> 4;
    const int n = item >> 3, g = item & 7, row0 = n * 128;
    bf16_t* UV = (bf16_t*)(p.ws + WS_R);
    const float* vst = (const float*)(p.ws + WS_VST);
    LAS bf16_t* VNT = (LAS bf16_t*)(lds + L_VNT); LAS bf16_t* WS = (LAS bf16_t*)(lds + L_WS);
    LAS float* MU = (LAS float*)(lds + L_MU); LAS float* RS = (LAS float*)(lds + L_RS);
    const int c0 = (tid & 31) * 8;
    f32x4 wv[8];
    { const float* wsrc = p.in[17] + (size_t)(o * 8 + g) * 16384;
#pragma unroll
      for (int i = 0; i < 8; ++i) { const int idx4 = tid + i * 512; wv[i] = *(const f32x4*)(wsrc + (idx4 >> 5) * 128 + (idx4 & 31) * 4); } }
    u32x4 qa[4], qb[4];
#pragma unroll
    for (int i = 0; i < 4; ++i) { const int s0 = ((tid >> 5) + i * 16) * 2;
        qa[i] = *(const u32x4*)(UV + (size_t)(row0 + s0) * 4096 + 2048 + g * 256 + c0);
        qb[i] = *(const u32x4*)(UV + (size_t)(row0 + s0 + 1) * 4096 + 2048 + g * 256 + c0); }
    u32x2 ur[8][2]; float bsv[8];
    { const float* bsp = p.in[18] + (size_t)(o * 8 + g) * 128;
#pragma unroll
      for (int tt = 0; tt < 8; ++tt) {
          const bf16_t* up = UV + (size_t)(row0 + 16 * tt + fr) * 4096 + g * 256 + 32 * w + 4 * fq;
          ur[tt][0] = *(const u32x2*)up; ur[tt][1] = *(const u32x2*)(up + 16); bsv[tt] = bsp[16 * tt + fr];
      } }
    const float* gp = p.in[15] + o * 2048 + g * 256 + c0; const float* bp = p.in[16] + o * 2048 + g * 256 + c0;
    const f32x4 g0 = *(const f32x4*)gp, g1 = *(const f32x4*)(gp + 4), h0 = *(const f32x4*)bp, h1 = *(const f32x4*)(bp + 4);
    if (tid < 128) { float sm = 0.f, sq = 0.f; const f32x4* vp = (const f32x4*)(vst + (size_t)(row0 + tid) * 64);
#pragma unroll
        for (int i = 0; i < 16; ++i) { const f32x4 t = vp[i]; sm += t[0] + t[2]; sq += t[1] + t[3]; }
        const float mean = sm * (1.0f / 2048.0f), var = fmaxf(sq * (1.0f / 2048.0f) - mean * mean, 0.f);
        MU[tid] = mean; RS[tid] = __builtin_amdgcn_rsqf(var + EPS); }
#pragma unroll
    for (int i = 0; i < 8; ++i) { const int idx4 = tid + i * 512, t = idx4 >> 5, s4 = (idx4 & 31) * 4;
        f32x4 v = wv[i];
        if (s4 >= 64 && t < 64) v = (f32x4){0.f, 0.f, 0.f, 0.f};
        *(LAS u32x2*)(WS + t * QS + s4) = pack4(v); }
    __syncthreads();
    { const float gg[8] = {g0[0], g0[1], g0[2], g0[3], g1[0], g1[1], g1[2], g1[3]}, hh[8] = {h0[0], h0[1], h0[2], h0[3], h1[0], h1[1], h1[2], h1[3]};
#pragma unroll
      for (int i = 0; i < 4; ++i) { const int s0 = ((tid >> 5) + i * 16) * 2;
          const float mua = MU[s0], rsa = RS[s0], mub = MU[s0 + 1], rsb = RS[s0 + 1];
          const float xa[8] = {bflo(qa[i][0]), bfhi(qa[i][0]), bflo(qa[i][1]), bfhi(qa[i][1]), bflo(qa[i][2]), bfhi(qa[i][2]), bflo(qa[i][3]), bfhi(qa[i][3])};
          const float xb[8] = {bflo(qb[i][0]), bfhi(qb[i][0]), bflo(qb[i][1]), bfhi(qb[i][1]), bflo(qb[i][2]), bfhi(qb[i][2]), bflo(qb[i][3]), bfhi(qb[i][3])};
#pragma unroll
          for (int j = 0; j < 8; ++j) *(LAS unsigned*)(VNT + (c0 + j) * QS + s0) = cvt_pk_bf16((xa[j] - mua) * rsa * gg[j] + hh[j], (xb[j] - mub) * rsb * gg[j] + hh[j]); } }
    __syncthreads();
    bf16x8 afr[2][4];
#pragma unroll
    for (int ct = 0; ct < 2; ++ct)
#pragma unroll
        for (int kk = 0; kk < 4; ++kk) afr[ct][kk] = ldfrag(VNT + (16 * (2 * w + ct) + fr) * QS + 8 * fq + 32 * kk);
#pragma unroll
    for (int tt = 0; tt < 8; ++tt) {
        f32x4 a0 = zero4(), a1 = zero4();
        const LAS bf16_t* wrow = WS + (16 * tt + fr) * QS + 8 * fq;
        { const bf16x8 bw0 = ldfrag(wrow), bw1 = ldfrag(wrow + 32);
          a0 = MFMA16(afr[0][0], bw0, a0); a1 = MFMA16(afr[1][0], bw0, a1);
          a0 = MFMA16(afr[0][1], bw1, a0); a1 = MFMA16(afr[1][1], bw1, a1); }
        if (tt >= 4) { const bf16x8 bw2 = ldfrag(wrow + 64), bw3 = ldfrag(wrow + 96);
          a0 = MFMA16(afr[0][2], bw2, a0); a1 = MFMA16(afr[1][2], bw2, a1);
          a0 = MFMA16(afr[0][3], bw3, a0); a1 = MFMA16(afr[1][3], bw3, a1); }
        bf16_t* up = UV + (size_t)(row0 + 16 * tt + fr) * 4096 + g * 256 + 32 * w + 4 * fq;
        *(u32x2*)up = pack4(unpack4(ur[tt][0]) * (a0 + bsv[tt]));
        *(u32x2*)(up + 16) = pack4(unpack4(ur[tt][1]) * (a1 + bsv[tt]));
    }
    __syncthreads();
}
__device__ __forceinline__ void gate_sample(const Params& p, LAS unsigned char* lds, int item, int o) {
    const int tid = fresh_tid(), b = item >> 3, g = item & 7, row0 = MP + b * 16;
    bf16_t* UV = (bf16_t*)(p.ws + WS_R);
    const float* vst = (const float*)(p.ws + WS_VST);
    LAS float* VN = (LAS float*)lds;
    LAS float* W16 = VN + 4096;
    LAS float* MU = W16 + 256; LAS float* RS = MU + 16;
    if (tid < 16) { float sm = 0.f, sq = 0.f; const f32x4* vp = (const f32x4*)(vst + (size_t)(row0 + tid) * 64);
        for (int i = 0; i < 16; ++i) { const f32x4 t = vp[i]; sm += t[0] + t[2]; sq += t[1] + t[3]; }
        const float mean = sm * (1.0f / 2048.0f), var = fmaxf(sq * (1.0f / 2048.0f) - mean * mean, 0.f);
        MU[tid] = mean; RS[tid] = __builtin_amdgcn_rsqf(var + EPS); }
    if (tid < 256) W16[tid] = p.in[17][(size_t)(o * 8 + g) * 16384 + (tid >> 4) * 128 + (tid & 15)];
    __syncthreads();
    for (int idx = tid; idx < 4096; idx += NTHR) { const int s = idx >> 8, c = idx & 255;
        const float x = bf2f(UV[(size_t)(row0 + s) * 4096 + 2048 + g * 256 + c]);
        const float vn = (x - MU[s]) * RS[s] * p.in[15][o * 2048 + g * 256 + c] + p.in[16][o * 2048 + g * 256 + c];
        VN[s * 256 + c] = vn;
        p.out[O_CV + ((size_t)(o * 16 + b) * 16 + s) * 2048 + g * 256 + c] = vn; }
    __syncthreads();
    { const int c = tid & 255, th = tid >> 8;
      for (int ti = 0; ti < 8; ++ti) { const int t = th * 8 + ti;
          float a = p.in[18][(size_t)(o * 8 + g) * 128 + t];
#pragma unroll
          for (int s = 0; s < 16; ++s) a += W16[t * 16 + s] * VN[s * 256 + c];
          bf16_t* up = UV + (size_t)(row0 + t) * 4096 + g * 256 + c;
          *up = f2bf(bf2f(*up) * a); } }
    __syncthreads();
}

__device__ __forceinline__ void ffn_eltwise(const Params& p, int l) {
    bf16_t* BIG = (bf16_t*)(p.ws + WS_R);
    const float* cw = p.in[21] + (size_t)l * 3 * 2816; const float* cb = p.in[22] + (size_t)l * 2816;
    const int nitems = (MA / 16) * 352;
    for (int it = blockIdx.x * NTHR + fresh_tid(); it < nitems; it += gridDim.x * NTHR) {
        const int cgp = it % 352, rr = it / 352, c0 = cgp * 8, row0 = rr * 16;
        const bool smp = row0 >= MP;
        const int t0 = smp ? 0 : (row0 & 4095);
        float w0[8], w1[8], w2[8], bs[8], am2[8], am1[8];
        { const f32x4 a = *(const f32x4*)(cw + c0), b = *(const f32x4*)(cw + c0 + 4); w0[0] = a[0]; w0[1] = a[1]; w0[2] = a[2]; w0[3] = a[3]; w0[4] = b[0]; w0[5] = b[1]; w0[6] = b[2]; w0[7] = b[3]; }
        { const f32x4 a = *(const f32x4*)(cw + 2816 + c0), b = *(const f32x4*)(cw + 2816 + c0 + 4); w1[0] = a[0]; w1[1] = a[1]; w1[2] = a[2]; w1[3] = a[3]; w1[4] = b[0]; w1[5] = b[1]; w1[6] = b[2]; w1[7] = b[3]; }
        { const f32x4 a = *(const f32x4*)(cw + 5632 + c0), b = *(const f32x4*)(cw + 5632 + c0 + 4); w2[0] = a[0]; w2[1] = a[1]; w2[2] = a[2]; w2[3] = a[3]; w2[4] = b[0]; w2[5] = b[1]; w2[6] = b[2]; w2[7] = b[3]; }
        { const f32x4 a = *(const f32x4*)(cb + c0), b = *(const f32x4*)(cb + c0 + 4); bs[0] = a[0]; bs[1] = a[1]; bs[2] = a[2]; bs[3] = a[3]; bs[4] = b[0]; bs[5] = b[1]; bs[6] = b[2]; bs[7] = b[3]; }
        if (t0 == 0) {
            if (smp) { const float* hp = p.in[4] + ((size_t)(l * 16 + ((row0 - MP) >> 4)) * 2) * 2816 + c0;
                const f32x4 a = *(const f32x4*)hp, b = *(const f32x4*)(hp + 4), c = *(const f32x4*)(hp + 2816), d = *(const f32x4*)(hp + 2816 + 4);
                am2[0] = a[0]; am2[1] = a[1]; am2[2] = a[2]; am2[3] = a[3]; am2[4] = b[0]; am2[5] = b[1]; am2[6] = b[2]; am2[7] = b[3];
                am1[0] = c[0]; am1[1] = c[1]; am1[2] = c[2]; am1[3] = c[3]; am1[4] = d[0]; am1[5] = d[1]; am1[6] = d[2]; am1[7] = d[3]; }
            else {
#pragma unroll
                for (int j = 0; j < 8; ++j) { am2[j] = 0.f; am1[j] = 0.f; } }
        } else {
            const u32x4 q2 = *(const u32x4*)(BIG + (size_t)(row0 - 2) * 5632 + c0), q1 = *(const u32x4*)(BIG + (size_t)(row0 - 1) * 5632 + c0);
            am2[0] = bflo(q2[0]); am2[1] = bfhi(q2[0]); am2[2] = bflo(q2[1]); am2[3] = bfhi(q2[1]); am2[4] = bflo(q2[2]); am2[5] = bfhi(q2[2]); am2[6] = bflo(q2[3]); am2[7] = bfhi(q2[3]);
            am1[0] = bflo(q1[0]); am1[1] = bfhi(q1[0]); am1[2] = bflo(q1[1]); am1[3] = bfhi(q1[1]); am1[4] = bflo(q1[2]); am1[5] = bfhi(q1[2]); am1[6] = bflo(q1[3]); am1[7] = bfhi(q1[3]);
        }
#pragma unroll 4
        for (int i = 0; i < 16; ++i) {
            bf16_t* rp = BIG + (size_t)(row0 + i) * 5632 + c0;
            const u32x4 qa = *(const u32x4*)rp, qg = *(const u32x4*)(rp + 2816);
            const float a[8] = {bflo(qa[0]), bfhi(qa[0]), bflo(qa[1]), bfhi(qa[1]), bflo(qa[2]), bfhi(qa[2]), bflo(qa[3]), bfhi(qa[3])};
            const float gt[8] = {bflo(qg[0]), bfhi(qg[0]), bflo(qg[1]), bfhi(qg[1]), bflo(qg[2]), bfhi(qg[2]), bflo(qg[3]), bfhi(qg[3])};
            float y[8];
#pragma unroll
            for (int j = 0; j < 8; j += 2) {
                const f32x2 cv = (f32x2){bs[j] + am2[j] * w0[j] + am1[j] * w1[j] + a[j] * w2[j], bs[j + 1] + am2[j + 1] * w0[j + 1] + am1[j + 1] * w1[j + 1] + a[j + 1] * w2[j + 1]};
                const f32x2 ge = gelu_pk(cv);
                y[j] = ge.x * gt[j]; y[j + 1] = ge.y * gt[j + 1];
            }
            *(u32x4*)(rp + 2816) = (u32x4){cvt_pk_bf16(y[0], y[1]), cvt_pk_bf16(y[2], y[3]), cvt_pk_bf16(y[4], y[5]), cvt_pk_bf16(y[6], y[7])};
#pragma unroll
            for (int j = 0; j < 8; ++j) { am2[j] = am1[j]; am1[j] = a[j]; }
        }
    }
    const int nst = 24 * 2 * 2816;
    for (int i = blockIdx.x * NTHR + fresh_tid(); i < nst; i += gridDim.x * NTHR) {
        const int c = i % 2816, j = (i / 2816) & 1, bb = i / 5632;
        if (bb < 8) p.out[O_CP + ((size_t)(l * 8 + bb) * 2 + j) * 2816 + c] = bf2f(BIG[(size_t)(bb * 4096 + 4094 + j) * 5632 + c]);
        else { const int b2 = bb - 8; p.out[O_CS + ((size_t)(l * 16 + b2) * 2 + j) * 2816 + c] = bf2f(BIG[(size_t)(MP + b2 * 16 + 14 + j) * 5632 + c]); }
    }
}


__device__ __forceinline__ void ffn_fixup(const Params& p, int l) {
    bf16_t* Y = (bf16_t*)(p.ws + WS_R + R_Y); const float* EDGE = (const float*)(p.ws + WS_R + R_EDGE); const bf16_t* SBUF = (const bf16_t*)(p.ws + WS_R + R_SBUF);
    const float* cw = p.in[21] + (size_t)l * 3 * 2816; const float* cb = p.in[22] + (size_t)l * 2816;
    const int gtid = blockIdx.x * NTHR + fresh_tid(), gth = gridDim.x * NTHR;
    for (int it = gtid; it < 128 * 4 * 352; it += gth) {
        const int c0 = (it % 352) * 8, r = (it / 352) & 3, pm = it / 1408;
        const float* e = EDGE + (size_t)pm * 12 * 2816 + c0; const float* ep = EDGE + (size_t)(pm - 1) * 12 * 2816 + c0;
        const bool first = (pm & 15) == 0;
        int kc, kg, k1, k2;
        if (r == 0) { kc = 0; kg = 2; k1 = first ? -1 : 12 + 11; k2 = first ? -1 : 12 + 10; }
        else if (r == 1) { kc = 1; kg = 3; k1 = 0; k2 = first ? -1 : 12 + 11; }
        else if (r == 2) { kc = 6; kg = 8; k1 = 5; k2 = 4; }
        else { kc = 7; kg = 9; k1 = 6; k2 = 5; }
        float y[8];
#pragma unroll
        for (int h = 0; h < 2; ++h) {
            const f32x4 cur = *(const f32x4*)(e + (size_t)kc * 2816 + 4 * h), gt = *(const f32x4*)(e + (size_t)kg * 2816 + 4 * h);
            const f32x4 z = (f32x4){0.f, 0.f, 0.f, 0.f};
            const f32x4 p1 = (k1 < 0) ? z : (k1 >= 12 ? *(const f32x4*)(ep + (size_t)(k1 - 12) * 2816 + 4 * h) : *(const f32x4*)(e + (size_t)k1 * 2816 + 4 * h));
            const f32x4 p2 = (k2 < 0) ? z : (k2 >= 12 ? *(const f32x4*)(ep + (size_t)(k2 - 12) * 2816 + 4 * h) : *(const f32x4*)(e + (size_t)k2 * 2816 + 4 * h));
            const f32x4 w0 = *(const f32x4*)(cw + c0 + 4 * h), w1 = *(const f32x4*)(cw + 2816 + c0 + 4 * h), w2 = *(const f32x4*)(cw + 5632 + c0 + 4 * h), bb = *(const f32x4*)(cb + c0 + 4 * h);
            const f32x4 ge = gelu4(bb + w0 * p2 + w1 * p1 + w2 * cur);
#pragma unroll
            for (int j = 0; j < 4; ++j) y[4 * h + j] = ge[j] * gt[j];
        }
        const int orow = pm * 256 + (r < 2 ? r : 126 + r);
        *(u32x4*)(Y + (size_t)orow * 2816 + c0) = (u32x4){cvt_pk_bf16(y[0], y[1]), cvt_pk_bf16(y[2], y[3]), cvt_pk_bf16(y[4], y[5]), cvt_pk_bf16(y[6], y[7])};
    }
    for (int it = gtid; it < 16 * 352; it += gth) {
        const int c0 = (it % 352) * 8, b = it / 352;
        float w0[8], w1[8], w2[8], bs[8], am2[8], am1[8];
        { const f32x4 a = *(const f32x4*)(cw + c0), bq = *(const f32x4*)(cw + c0 + 4), c = *(const f32x4*)(cw + 2816 + c0), d = *(const f32x4*)(cw + 2816 + c0 + 4);
          const f32x4 e = *(const f32x4*)(cw + 5632 + c0), f = *(const f32x4*)(cw + 5632 + c0 + 4), g = *(const f32x4*)(cb + c0), h = *(const f32x4*)(cb + c0 + 4);
#pragma unroll
          for (int j = 0; j < 4; ++j) { w0[j] = a[j]; w0[4 + j] = bq[j]; w1[j] = c[j]; w1[4 + j] = d[j]; w2[j] = e[j]; w2[4 + j] = f[j]; bs[j] = g[j]; bs[4 + j] = h[j]; } }
        { const float* hp = p.in[4] + ((size_t)(l * 16 + b) * 2) * 2816 + c0;
          const f32x4 a = *(const f32x4*)hp, bq = *(const f32x4*)(hp + 4), c = *(const f32x4*)(hp + 2816), d = *(const f32x4*)(hp + 2816 + 4);
#pragma unroll
          for (int j = 0; j < 4; ++j) { am2[j] = a[j]; am2[4 + j] = bq[j]; am1[j] = c[j]; am1[4 + j] = d[j]; } }
#pragma unroll 4
        for (int i = 0; i < 16; ++i) {
            const bf16_t* rp = SBUF + (size_t)(b * 16 + i) * 5632 + c0;
            const u32x4 qa = *(const u32x4*)rp, qg = *(const u32x4*)(rp + 2816);
            const float a[8] = {bflo(qa[0]), bfhi(qa[0]), bflo(qa[1]), bfhi(qa[1]), bflo(qa[2]), bfhi(qa[2]), bflo(qa[3]), bfhi(qa[3])};
            const float gt[8] = {bflo(qg[0]), bfhi(qg[0]), bflo(qg[1]), bfhi(qg[1]), bflo(qg[2]), bfhi(qg[2]), bflo(qg[3]), bfhi(qg[3])};
            float y[8];
#pragma unroll
            for (int j = 0; j < 8; j += 2) {
                const f32x2 cv = (f32x2){bs[j] + am2[j] * w0[j] + am1[j] * w1[j] + a[j] * w2[j], bs[j + 1] + am2[j + 1] * w0[j + 1] + am1[j + 1] * w1[j + 1] + a[j + 1] * w2[j + 1]};
                const f32x2 ge = gelu_pk(cv);
                y[j] = ge.x * gt[j]; y[j + 1] = ge.y * gt[j + 1];
            }
            *(u32x4*)(Y + (size_t)(MP + b * 16 + i) * 2816 + c0) = (u32x4){cvt_pk_bf16(y[0], y[1]), cvt_pk_bf16(y[2], y[3]), cvt_pk_bf16(y[4], y[5]), cvt_pk_bf16(y[6], y[7])};
#pragma unroll
            for (int j = 0; j < 8; ++j) { am2[j] = am1[j]; am1[j] = a[j]; }
        }
    }
    for (int i = gtid; i < 24 * 2 * 2816; i += gth) {
        const int c = i % 2816, j = (i / 2816) & 1, bb = i / 5632;
        if (bb < 8) p.out[O_CP + ((size_t)(l * 8 + bb) * 2 + j) * 2816 + c] = EDGE[((size_t)(bb * 16 + 15) * 12 + 10 + j) * 2816 + c];
        else { const int b2 = bb - 8; p.out[O_CS + ((size_t)(l * 16 + b2) * 2 + j) * 2816 + c] = bf2f(SBUF[(size_t)(b2 * 16 + 14 + j) * 5632 + c]); }
    }
}

__device__ __forceinline__ void final_norm(const Params& p) {
    const float* ss = (const float*)(p.ws + WS_SS) + (size_t)8 * MA * 16;
    const bf16_t* Xb = (const bf16_t*)(p.ws + WS_XB);
    const int tid = fresh_tid(), wave = tid >> 6, lane = tid & 63;
    f32x4 gn[4];
#pragma unroll
    for (int j = 0; j < 4; ++j) gn[j] = *(const f32x4*)(p.in[7] + (j >> 1) * 512 + lane * 8 + (j & 1) * 4);
#pragma unroll 2
    for (int row = blockIdx.x * 8 + wave; row < MA; row += gridDim.x * 8) {
        const float rs = row_rstd(ss, row);
        float* yp = p.out + (size_t)row * 1024;
#pragma unroll
        for (int hh = 0; hh < 2; ++hh) {
            const u32x4 q = *(const u32x4*)(Xb + (size_t)row * 1024 + hh * 512 + lane * 8);
            const f32x4 v0 = (f32x4){bflo(q[0]), bfhi(q[0]), bflo(q[1]), bfhi(q[1])} * rs * gn[hh * 2];
            const f32x4 v1 = (f32x4){bflo(q[2]), bfhi(q[2]), bflo(q[3]), bfhi(q[3])} * rs * gn[hh * 2 + 1];
            *(f32x4*)(yp + hh * 512 + lane * 8) = v0; *(f32x4*)(yp + hh * 512 + lane * 8 + 4) = v1;
        }
    }
}

__device__ __forceinline__ void dbg_rowsum_bf16(const bf16_t* src, int rows, size_t ld, int ncols, float* dst) {
    const int wave = threadIdx.x >> 6, lane = threadIdx.x & 63;
    for (int r = blockIdx.x * 8 + wave; r < rows; r += gridDim.x * 8) {
        float s = 0.f;
        for (int c = lane; c < ncols; c += 64) s += bf2f(src[(size_t)r * ld + c]);
        for (int o = 32; o >= 1; o >>= 1) s += __shfl_xor(s, o);
        if (lane == 0) dst[r] = s;
    }
}
__device__ __forceinline__ void dbg_dump(const Params& p, int kind) {
    if (kind == 1) { const float* ss = (const float*)(p.ws + WS_SS); for (int i = blockIdx.x * NTHR + threadIdx.x; i < 9 * MA * 16; i += gridDim.x * NTHR) p.out[i] = ss[i]; }
    else if (kind == 2) { dbg_rowsum_bf16((const bf16_t*)(p.ws + WS_R), MA, 5632, 2816, p.out); dbg_rowsum_bf16((const bf16_t*)(p.ws + WS_R) + 2816, MA, 5632, 2816, p.out + MA); }
    else if (kind == 3) { dbg_rowsum_bf16((const bf16_t*)(p.ws + WS_W0), 14592, 1024, 1024, p.out); dbg_rowsum_bf16((const bf16_t*)(p.ws + WS_W0 + SLOT_BYTES), 14592, 1024, 1024, p.out + 14592); }
    else if (kind == 4) { dbg_rowsum_bf16((const bf16_t*)(p.ws + WS_XB), MA, 1024, 1024, p.out); }
}

#define XB_TMO      128
#define XB_XCNT(j)  (256  + 64 * (j))
#define XB_XSUB(j)  (1280 + 64 * (j))
#define XB_XGEN(j)  (2304 + 64 * (j))
#define XB_TOP      3328
#define XB_TOPGEN   3392
#define XCD_BAR_WORDS 3456
#define XB_SPIN_CAP (1u << 18)
__device__ __forceinline__ unsigned xb_ld(unsigned* p)              { return __hip_atomic_load(p, __ATOMIC_RELAXED, __HIP_MEMORY_SCOPE_AGENT); }
__device__ __forceinline__ unsigned xb_add(unsigned* p, unsigned v) { return __hip_atomic_fetch_add(p, v, __ATOMIC_RELAXED, __HIP_MEMORY_SCOPE_AGENT); }
__device__ __forceinline__ unsigned xb_xcc_id() { return (unsigned)__builtin_amdgcn_s_getreg((3 << 11) | 20) & 0xFu; }
#define XB_SPIN(cond, bar) do { unsigned _sp = 0; while (cond) { __builtin_amdgcn_s_sleep(1); \
    if ((++_sp & 255u) == 0u) { if (xb_ld(&(bar)[XB_TMO])) break; if (_sp > XB_SPIN_CAP) { atomicAdd(&(bar)[XB_TMO], 1u); break; } } } } while (0)
struct XcdBarrier { unsigned* bar; unsigned x; volatile LAS unsigned* st; };
__device__ __forceinline__ XcdBarrier xcd_barrier_post(unsigned* bar, volatile LAS unsigned* st) {
    XcdBarrier b; b.bar = bar; b.x = xb_xcc_id(); b.st = st;
    if (threadIdx.x == 0) (void)xb_add(&bar[XB_XCNT(b.x)], 1u);
    return b;
}
__device__ __forceinline__ void xcd_barrier_complete(unsigned* bar, unsigned x, unsigned& nloc, unsigned& nx) {
    const unsigned G = gridDim.x * gridDim.y * gridDim.z;
    unsigned sum, cnt, mine, sp = 0u;
    for (;;) {
        sum = 0u; cnt = 0u; mine = 0u;
#pragma unroll
        for (unsigned j = 0; j < 16; ++j) { const unsigned c = xb_ld(&bar[XB_XCNT(j)]); sum += c; cnt += (c > 0u) ? 1u : 0u; mine = (j == x) ? c : mine; }
        if (sum == G) break;
        __builtin_amdgcn_s_sleep(1);
        if ((++sp & 255u) == 0u) { if (xb_ld(&bar[XB_TMO])) break; if (sp > XB_SPIN_CAP) { atomicAdd(&bar[XB_TMO], 1u); break; } }
    }
    nloc = mine > 0u ? mine : 1u; nx = cnt > 0u ? cnt : 1u;
}
__device__ __forceinline__ void xcd_barrier(const XcdBarrier& b) {
    asm volatile("s_waitcnt vmcnt(0)" ::: "memory");
    __syncthreads();
    if (threadIdx.x == 0) {
        unsigned* bar = b.bar;
        __builtin_amdgcn_s_waitcnt(0);
        unsigned nloc = b.st[0], nx = b.st[1];
        if (nloc == 0u) { xcd_barrier_complete(bar, b.x, nloc, nx); b.st[0] = nloc; b.st[1] = nx; }
        const unsigned old = xb_add(&bar[XB_XSUB(b.x)], 1u);
        const unsigned gen = old / nloc;
        if (old + 1u == (gen + 1u) * nloc) {
            __builtin_amdgcn_fence(__ATOMIC_RELEASE, "agent");
            asm volatile("s_waitcnt vmcnt(0)" ::: "memory");
            const unsigned og = xb_add(&bar[XB_TOP], 1u);
            const unsigned tg = og / nx;
            if (og + 1u == (tg + 1u) * nx) xb_add(&bar[XB_TOPGEN], 1u);
            else XB_SPIN(xb_ld(&bar[XB_TOPGEN]) == tg, bar);
            __builtin_amdgcn_fence(__ATOMIC_ACQUIRE, "agent");
            xb_add(&bar[XB_XGEN(b.x)], 1u);
            asm volatile("s_waitcnt vmcnt(0)" ::: "memory");
        } else {
            XB_SPIN(xb_ld(&bar[XB_XGEN(b.x)]) == gen, bar);
            __builtin_amdgcn_fence(__ATOMIC_ACQUIRE, "agent");
            asm volatile("s_waitcnt vmcnt(0)" ::: "memory");
        }
    }
    __syncthreads();
}

__global__ void __launch_bounds__(NTHR, 2) mega(Params p) {
    extern __shared__ __attribute__((aligned(16))) unsigned char shm[];
    LAS unsigned char* lds = (LAS unsigned char*)shm;
    cg::grid_group grid = cg::this_grid();
    const int bid = blockIdx.x, nb = gridDim.x;
    int ph = 0;
#define ACTIVE() (p.ph_lo <= ph && ph < p.ph_hi)
#define STRONG_SYNC() do { asm volatile("s_waitcnt vmcnt(0) lgkmcnt(0)" ::: "memory"); grid.sync(); \
        if (threadIdx.x < 64) { __builtin_amdgcn_fence(__ATOMIC_ACQUIRE, "agent"); asm volatile("s_waitcnt vmcnt(0)" ::: "memory"); } __syncthreads(); } while (0)
#define SEAM() do { if (p.ph_lo <= ph && ph + 1 < p.ph_hi) { if (p.ph_hi < 0) STRONG_SYNC(); xcd_barrier(xbar); } ++ph; } while (0)
    float* ss = (float*)(p.ws + WS_SS);
    bf16_t* Xb = (bf16_t*)(p.ws + WS_XB);
    if (threadIdx.x < 4) ((volatile LAS unsigned*)(lds + 135168))[threadIdx.x] = 0u;
    __syncthreads();
    const XcdBarrier xbar = xcd_barrier_post((unsigned*)(p.ws + WS_BAR), (volatile LAS unsigned*)(lds + 135168));
    if (ACTIVE() && (PHM & 1)) phase0(p, lds);
    SEAM();
    for (int l = 0; l < 4; ++l) {
        const bf16_t* slot = (const bf16_t*)(p.ws + WS_W0 + (size_t)(l & 1) * SLOT_BYTES);
        const int h = l >> 1;
        size_t ffo_in, ffo_out;
        if ((l & 1) == 0) {
            ffo_in = 3670016; ffo_out = 9437184;
            if (ACTIVE() && (PHM & 2)) {
                pg8::Gemm g{Xb, slot, MP, 2560, 1024, 1024}; pg8::StaticOrder S; S.init(MP, 2560, nb, bid);
                EpiAB E{(bf16_t*)(p.ws + WS_R + R_PROJ), (float*)(p.ws + WS_R + R_LF), ss + (size_t)(2 * l) * MA * 16, (const float*)(p.ws + WS_LB) + h * 512};
                pg8::gemm_phase(lds, g, S, E);
                SEpiAB SE{E.PROJ, E.LF, E.ssin, E.lb};
                sample_gemm(lds, Xb + (size_t)MP * 1024, 1024, slot, 1024, 2560, SE);
            }
            SEAM();
            if (ACTIVE() && (PHM & 4)) {
                for (int item = bid; item < 2048; item += nb) hgrn_pass1(p, lds, item);
                for (int item = nb - 1 - bid; item < 64; item += nb) hgrn_sample(p, lds, item, h);
                pool_phase(p, h);
                if (l == 2) prep_layer(p, lds, 3);
            }
            SEAM();
            if (ACTIVE() && (PHM & 8)) hgrn_pass2(p, h);
            SEAM();
            if (ACTIVE() && (PHM & 16)) { for (int item = bid; item < 2048; item += nb) hgrn_pass3(p, lds, item, h); }
            SEAM();
            if (ACTIVE() && (PHM & 32)) {
                pg8::Gemm g{(const bf16_t*)(p.ws + WS_R + R_A2), slot + 2621440, MP, 1024, 1024, 1024}; pg8::StaticOrder S; S.init(MP, 1024, nb, bid);
                EpiRes E{Xb, ss + (size_t)(2 * l + 1) * MA * 16};
                pg8::gemm_phase(lds, g, S, E);
                SEpiRes SE{Xb, E.ssout};
                sample_gemm(lds, (const bf16_t*)(p.ws + WS_R + R_A2) + (size_t)MP * 1024, 1024, slot + 2621440, 1024, 1024, SE);
            }
            SEAM();
        } else {
            ffo_in = 6291456; ffo_out = 12058624;
            if (ACTIVE() && (PHM & 64)) {
                pg8::Gemm g{Xb, slot, MP, 4096, 1024, 1024}; pg8::StaticOrder S; S.init(MP, 4096, nb, bid);
                EpiUV E{(bf16_t*)(p.ws + WS_R), ss + (size_t)(2 * l) * MA * 16, (float*)(p.ws + WS_VST)};
                pg8::gemm_phase(lds, g, S, E);
                SEpiUV SE{E.UV, E.ssin, E.vst};
                sample_gemm(lds, Xb + (size_t)MP * 1024, 1024, slot, 1024, 4096, SE);
            }
            SEAM();
            if (ACTIVE() && (PHM & 128)) {
                for (int item = bid; item < 2048; item += nb) gate_item(p, lds, item, h);
                for (int item = nb - 1 - bid; item < 128; item += nb) gate_sample(p, lds, item, h);
                if (l == 1) prep_layer(p, lds, 2);
            }
            SEAM();
            if (ACTIVE() && (PHM & 256)) {
                pg8::Gemm g{(const bf16_t*)(p.ws + WS_R), slot + 4194304, MP, 1024, 2048, 4096}; pg8::StaticOrder S; S.init(MP, 1024, nb, bid);
                EpiRes E{Xb, ss + (size_t)(2 * l + 1) * MA * 16};
                pg8::gemm_phase(lds, g, S, E);
                SEpiRes SE{Xb, E.ssout};
                sample_gemm(lds, (const bf16_t*)(p.ws + WS_R) + (size_t)MP * 4096, 4096, slot + 4194304, 2048, 1024, SE);
            }
            SEAM();
        }
        if (ACTIVE() && (PHM & 512)) {
            pg8::Gemm g{Xb, slot + ffo_in, MP, 5632, 1024, 1024}; pg8::StaticOrder S; S.init(MP, 5632, nb, bid);
            EpiFF2 E{(bf16_t*)(p.ws + WS_R + R_Y), (float*)(p.ws + WS_R + R_EDGE), ss + (size_t)(2 * l + 1) * MA * 16, p.in[21] + (size_t)l * 3 * 2816, p.in[22] + (size_t)l * 2816};
            pg8::gemm_phase(lds, g, S, E);
            SEpiFF2 SE{(bf16_t*)(p.ws + WS_R + R_SBUF), E.ssin};
            sample_gemm(lds, Xb + (size_t)MP * 1024, 1024, slot + ffo_in, 1024, 5632, SE);
        }
        SEAM();
        if (ACTIVE() && (PHM & 1024)) ffn_fixup(p, l);
        SEAM();
        if (ACTIVE() && (PHM & 2048)) {
            pg8::Gemm g{(const bf16_t*)(p.ws + WS_R + R_Y), slot + ffo_out, MP, 1024, 2816, 2816}; pg8::StaticOrder S; S.init(MP, 1024, nb, bid);
            EpiRes E{Xb, ss + (size_t)(2 * l + 2) * MA * 16};
            pg8::gemm_phase(lds, g, S, E);
            SEpiRes SE{Xb, E.ssout};
            sample_gemm(lds, (const bf16_t*)(p.ws + WS_R + R_Y) + (size_t)MP * 2816, 2816, slot + ffo_out, 2816, 1024, SE);
        }
        SEAM();
    }
    if (ACTIVE() && (PHM & 4096)) final_norm(p);
#undef ACTIVE
#undef SEAM
}
constexpr int N_PHASES = 1 + 2 * 8 + 2 * 6 + 1;

extern "C" void kernel_launch(void* const* d_in, const int* in_sizes, int n_in, void* d_out, int out_size, void* d_ws, size_t ws_size, hipStream_t stream) {
    static int grid = 0;
    if (grid == 0) {
        if (n_in != 24 || (size_t)out_size != O_END || ws_size < WS_END) { fprintf(stderr, "kernel_launch: unexpected shapes (n_in %d, out %d, ws %zu, need %zu)\n", n_in, out_size, ws_size, (size_t)WS_END); grid = -1; return; }
        int dev = 0, cus = 0, per_cu = 0;
        hipGetDevice(&dev); hipDeviceGetAttribute(&cus, hipDeviceAttributeMultiprocessorCount, dev);
        if (hipFuncSetAttribute((const void*)mega, hipFuncAttributeMaxDynamicSharedMemorySize, LDS_BYTES) != hipSuccess) { fprintf(stderr, "kernel_launch: hipFuncSetAttribute failed\n"); grid = -1; return; }
        if (hipOccupancyMaxActiveBlocksPerMultiprocessor(&per_cu, (const void*)mega, NTHR, LDS_BYTES) != hipSuccess || per_cu < 1) { fprintf(stderr, "kernel_launch: occupancy query says %d\n", per_cu); per_cu = 1; }
        (void)hipGetLastError();
        grid = cus;
    }
    if (grid < 0) return;
    if (hipMemsetAsync((char*)d_ws + WS_BAR, 0, XCD_BAR_WORDS * 4, stream) != hipSuccess) { fprintf(stderr, "kernel_launch: memset of the barrier words failed\n"); return; }
    Params p{};
    for (int i = 0; i < 24; ++i) p.in[i] = (const float*)d_in[i];
    p.out = (float*)d_out; p.ws = (unsigned char*)d_ws;
#if MULTI_LAUNCH
    for (int ph = 0; ph < N_PHASES; ++ph) { p.ph_lo = ph; p.ph_hi = ph + 1; hipLaunchKernelGGL(mega, dim3(grid), dim3(NTHR), LDS_BYTES, stream, p); }
#else
    p.ph_lo = 0; p.ph_hi = (PH_CUT < N_PHASES) ? PH_CUT : N_PHASES; p.dbg = DBG_PHASE; p.pad = DBG_KIND;
    void* args[] = {&p};
    hipError_t e = hipLaunchCooperativeKernel((const void*)mega, dim3(grid), dim3(NTHR), args, LDS_BYTES, stream);
    if (e != hipSuccess) fprintf(stderr, "cooperative launch failed: %s (grid %d)\n", hipGetErrorString(e), grid);
#endif
}
```
